# Optimizing an MI355X kernel written in HIP

```python
import jax, jax.numpy as jnp
from jax import lax
import numpy as np

D_MODEL = 1024
BATCH = 8
SEQ = 2048
DEPTH = 1

HEAD_DIM = 64
N_Q_HEADS = 8
N_KV_HEADS = 2
Q_PER_KV = N_Q_HEADS // N_KV_HEADS
ATTN_WIDTH = N_Q_HEADS * HEAD_DIM
KV_WIDTH = N_KV_HEADS * HEAD_DIM
WINDOW = 128
BLOCK = 128
LRU_WIDTH = D_MODEL - ATTN_WIDTH
LRU_HEADS = 8
LRU_HEAD_DIM = LRU_WIDTH // LRU_HEADS
LRU_CONV_WIDTH = 4
LRU_C = 8.0
MIX_WIDTH = ATTN_WIDTH + LRU_WIDTH
IN_WIDTH = ATTN_WIDTH + 2 * KV_WIDTH + 2 * LRU_WIDTH
D_FF = 2816
FFN_CONV_WIDTH = 3
RMS_EPS = 1e-6

kernel_name = "hymba_swa_sink_rglru_convffn_sandwich"


def rmsnorm(x, g):
    xf = x.astype(jnp.float32)
    y = xf * lax.rsqrt(jnp.mean(xf * xf, axis=-1, keepdims=True) + RMS_EPS)
    return (y * g.astype(jnp.float32)).astype(x.dtype)


def causal_dwconv(x, w, b):
    K = w.shape[0]
    S = x.shape[1]
    xp = jnp.pad(x, ((0, 0), (K - 1, 0), (0, 0)))
    y = xp[:, 0:S] * w[0]
    for k in range(1, K):
        y = y + xp[:, k:k + S] * w[k]
    return y + b


def alibi_slopes(n_heads):
    h = jnp.arange(1, n_heads + 1, dtype=jnp.float32)
    return jnp.exp2(-8.0 * h / n_heads)


def sliding_window_attention(q, k, v, sinks):
    B, S, _ = q.shape
    nb = S // BLOCK
    qb = q.reshape(B, nb, BLOCK, N_KV_HEADS, Q_PER_KV, HEAD_DIM)
    kb = k.reshape(B, nb, BLOCK, N_KV_HEADS, HEAD_DIM)
    vb = v.reshape(B, nb, BLOCK, N_KV_HEADS, HEAD_DIM)

    def with_prev(t):
        prev = jnp.pad(t[:, :-1], ((0, 0), (1, 0), (0, 0), (0, 0), (0, 0)))
        return jnp.concatenate([prev, t], axis=2)

    kk = with_prev(kb)
    vv = with_prev(vb)
    scale = HEAD_DIM ** -0.5
    scores = jnp.einsum('bnqhgd,bnkhd->bnhgqk', qb, kk).astype(jnp.float32) * scale

    qi = jnp.arange(BLOCK)[:, None]
    ki = jnp.arange(2 * BLOCK)[None, :]
    dist = (BLOCK + qi - ki)
    in_window = (dist >= 0) & (dist < WINDOW)
    key_exists = (jnp.arange(nb)[:, None, None] > 0) | (ki >= BLOCK)[None]
    mask = in_window[None] & key_exists

    slopes = alibi_slopes(N_Q_HEADS).reshape(N_KV_HEADS, Q_PER_KV)
    bias = -slopes[:, :, None, None] * dist.astype(jnp.float32)
    logits = scores + bias[None, None]
    logits = jnp.where(mask[None, :, None, None], logits, jnp.finfo(jnp.float32).min)

    s = sinks.astype(jnp.float32).reshape(N_KV_HEADS, Q_PER_KV)
    sink_col = jnp.broadcast_to(s[None, None, :, :, None, None], logits.shape[:-1] + (1,))
    probs = jax.nn.softmax(jnp.concatenate([logits, sink_col], axis=-1), axis=-1)[..., :-1]
    out = jnp.einsum('bnhgqk,bnkhd->bnqhgd', probs.astype(v.dtype), vv)
    return out.reshape(B, S, ATTN_WIDTH)


def rg_lru(x, w_a, b_a, w_x, b_x, lam):
    B, S, _ = x.shape
    xh = x.reshape(B, S, LRU_HEADS, LRU_HEAD_DIM)
    r = jax.nn.sigmoid(jnp.einsum('bshi,hij->bshj', xh, w_a).reshape(B, S, LRU_WIDTH) + b_a)
    i = jax.nn.sigmoid(jnp.einsum('bshi,hij->bshj', xh, w_x).reshape(B, S, LRU_WIDTH) + b_x)
    log_a = -LRU_C * r.astype(jnp.float32) * jax.nn.softplus(-lam.astype(jnp.float32))
    a = jnp.exp(log_a)
    mult = jnp.sqrt(-jnp.expm1(2.0 * log_a))
    u = mult * (i * x).astype(jnp.float32)

    def combine(left, right):
        a_l, b_l = left
        a_r, b_r = right
        return a_l * a_r, a_r * b_l + b_r

    _, h = lax.associative_scan(combine, (a, u), axis=1)
    return h.astype(x.dtype)


def setup_inputs(seed: int = 0) -> dict:
    key = jax.random.key(seed)
    ks = jax.random.split(key, 24)
    f32 = jnp.float32

    def nrm(k, shape, scale):
        return jax.random.normal(k, shape, f32) * scale

    def gain(k, n):
        return 1.0 + 0.05 * jax.random.normal(k, (DEPTH, n), f32)

    x = jax.random.normal(ks[0], (BATCH, SEQ, D_MODEL), f32)
    a0 = jax.random.uniform(ks[10], (DEPTH, LRU_WIDTH), f32, 0.9, 0.999)
    base = a0 ** (1.0 / LRU_C)
    lru_lambda = jnp.log(base) - jnp.log1p(-base)
    return {
        "x": x,
        "norm_mix_pre": gain(ks[1], D_MODEL),
        "w_in": nrm(ks[2], (DEPTH, D_MODEL, IN_WIDTH), D_MODEL ** -0.5),
        "sinks": nrm(ks[3], (DEPTH, N_Q_HEADS), 0.5),
        "lru_conv_w": nrm(ks[4], (DEPTH, LRU_CONV_WIDTH, LRU_WIDTH), LRU_CONV_WIDTH ** -0.5),
        "lru_conv_b": nrm(ks[5], (DEPTH, LRU_WIDTH), 0.01),
        "lru_wa": nrm(ks[6], (DEPTH, LRU_HEADS, LRU_HEAD_DIM, LRU_HEAD_DIM), LRU_HEAD_DIM ** -0.5),
        "lru_ba": nrm(ks[7], (DEPTH, LRU_WIDTH), 0.01),
        "lru_wx": nrm(ks[8], (DEPTH, LRU_HEADS, LRU_HEAD_DIM, LRU_HEAD_DIM), LRU_HEAD_DIM ** -0.5),
        "lru_bx": nrm(ks[9], (DEPTH, LRU_WIDTH), 0.01),
        "lru_lambda": lru_lambda,
        "norm_attn_out": gain(ks[11], ATTN_WIDTH),
        "norm_lru_out": gain(ks[12], LRU_WIDTH),
        "w_out": nrm(ks[13], (DEPTH, MIX_WIDTH, D_MODEL), MIX_WIDTH ** -0.5),
        "norm_mix_post": gain(ks[14], D_MODEL),
        "norm_ffn_pre": gain(ks[15], D_MODEL),
        "w_up": nrm(ks[16], (DEPTH, D_MODEL, 2 * D_FF), D_MODEL ** -0.5),
        "ffn_conv_w": nrm(ks[17], (DEPTH, FFN_CONV_WIDTH, 2 * D_FF), FFN_CONV_WIDTH ** -0.5),
        "ffn_conv_b": nrm(ks[18], (DEPTH, 2 * D_FF), 0.01),
        "w_down": nrm(ks[19], (DEPTH, D_FF, D_MODEL), D_FF ** -0.5),
        "norm_ffn_post": gain(ks[20], D_MODEL),
    }


def reference(x, norm_mix_pre, w_in, sinks, lru_conv_w, lru_conv_b, lru_wa, lru_ba,
              lru_wx, lru_bx, lru_lambda, norm_attn_out, norm_lru_out, w_out,
              norm_mix_post, norm_ffn_pre, w_up, ffn_conv_w, ffn_conv_b, w_down,
              norm_ffn_post):
    splits = [ATTN_WIDTH, ATTN_WIDTH + KV_WIDTH, ATTN_WIDTH + 2 * KV_WIDTH,
              ATTN_WIDTH + 2 * KV_WIDTH + LRU_WIDTH]
    for l in range(DEPTH):
        h = rmsnorm(x, norm_mix_pre[l])
        proj = h @ w_in[l]
        q, k, v, lx, lg = jnp.split(proj, splits, axis=-1)
        attn = sliding_window_attention(q, k, v, sinks[l])
        lx = causal_dwconv(lx, lru_conv_w[l], lru_conv_b[l])
        lru = rg_lru(lx, lru_wa[l], lru_ba[l], lru_wx[l], lru_bx[l], lru_lambda[l])
        lru = lru * jax.nn.gelu(lg, approximate=True)
        merged = jnp.concatenate([rmsnorm(attn, norm_attn_out[l]),
                                  rmsnorm(lru, norm_lru_out[l])], axis=-1)
        x = x + rmsnorm(merged @ w_out[l], norm_mix_post[l])
        f = rmsnorm(x, norm_ffn_pre[l]) @ w_up[l]
        f = causal_dwconv(f, ffn_conv_w[l], ffn_conv_b[l])
        gate, val = jnp.split(f, 2, axis=-1)
        f = (jax.nn.gelu(gate, approximate=True) * val) @ w_down[l]
        x = x + rmsnorm(f, norm_ffn_post[l])
    return x
```

```cpp
#include <hip/hip_runtime.h>
#include <hip/hip_cooperative_groups.h>
#include <cstdio>
#include <cstdint>
namespace cg = cooperative_groups;

#ifndef MK_N_LAUNCHES
#define MK_N_LAUNCHES 1
#endif

#define LAS __attribute__((address_space(3)))
typedef unsigned short bf16_t;
typedef short bf16x8 __attribute__((ext_vector_type(8)));
typedef float f32x4 __attribute__((ext_vector_type(4)));
typedef float f32x2 __attribute__((ext_vector_type(2)));
typedef unsigned u32x4 __attribute__((ext_vector_type(4)));
typedef unsigned u32x2 __attribute__((ext_vector_type(2)));

constexpr int BATCH = 8, SEQ = 2048, DM = 1024, M = BATCH * SEQ;
constexpr int INW = 1792, DFF = 2816, NUP = 2 * DFF;
constexpr int KOFF = 512, VOFF = 640, LXOFF = 768, LGOFF = 1280;
constexpr float RMS_EPS = 1e-6f;
constexpr float LOG2E = 1.4426950408889634f;

constexpr size_t MiB = 1u << 20;
constexpr size_t WS_WIN = 1 * MiB;
constexpr size_t WS_WOUT = 5 * MiB;
constexpr size_t WS_WUP = 7 * MiB;
constexpr size_t WS_WDN = 18 * MiB;
constexpr size_t WS_WAT = 23 * MiB + 512 * 1024;
constexpr size_t WS_SUMM = 24 * MiB;
constexpr size_t WS_HN = 26 * MiB;
constexpr size_t WS_R1 = 58 * MiB;
constexpr size_t WS_MERGED = 122 * MiB;
constexpr size_t WS_HL = 154 * MiB;
constexpr size_t WS_ACUM = 170 * MiB;
constexpr size_t WS_G = 154 * MiB;
constexpr size_t WS_EDGE = 242 * MiB;
constexpr size_t WS_XB = 25 * MiB;
constexpr size_t WS_END = 254 * MiB;

constexpr int LDS_BYTES = 163840;

__device__ __forceinline__ unsigned cvt_pk_bf16(float lo, float hi) { unsigned r; asm volatile("v_cvt_pk_bf16_f32 %0, %1, %2" : "=v"(r) : "v"(lo), "v"(hi)); return r; }
__device__ __forceinline__ float bf_lo(unsigned w) { return __uint_as_float(w << 16); }
__device__ __forceinline__ float bf_hi(unsigned w) { return __uint_as_float(w & 0xffff0000u); }
__device__ __forceinline__ float fast_exp2(float x) { return __builtin_amdgcn_exp2f(x); }
__device__ __forceinline__ float fast_rcp(float x) { return __builtin_amdgcn_rcpf(x); }
__device__ __forceinline__ float sigmoidf_(float z) { return fast_rcp(1.0f + fast_exp2(-LOG2E * z)); }
__device__ __forceinline__ float gelu_tanh(float x) {
    const float u = x * (1.0f + 0.044715f * x * x);
    return x * fast_rcp(1.0f + fast_exp2(-2.0f * 0.7978845608028654f * LOG2E * u));
}
__device__ __forceinline__ f32x4 gelu_tanh4(f32x4 x) {
    const f32x4 u = x * (x * x * 0.044715f + 1.0f);
    const f32x4 t = u * (-2.0f * 0.7978845608028654f * LOG2E);
    f32x4 e; e.x = fast_exp2(t.x); e.y = fast_exp2(t.y); e.z = fast_exp2(t.z); e.w = fast_exp2(t.w);
    const f32x4 d = e + 1.0f;
    f32x4 r; r.x = fast_rcp(d.x); r.y = fast_rcp(d.y); r.z = fast_rcp(d.z); r.w = fast_rcp(d.w);
    return x * r;
}
template <int CTRL> __device__ __forceinline__ float dpp_keep(float oldv, float v) {
    return __int_as_float(__builtin_amdgcn_update_dpp(__float_as_int(oldv), __float_as_int(v), CTRL, 0xf, 0xf, false));
}
template <int CTRL> __device__ __forceinline__ float dpp_zf(float v) {
    return __int_as_float(__builtin_amdgcn_update_dpp(0, __float_as_int(v), CTRL, 0xf, 0xf, true));
}
template <int CTRL> __device__ __forceinline__ float dpp_rot(float v) {
    return __int_as_float(__builtin_amdgcn_mov_dpp(__float_as_int(v), CTRL, 0xf, 0xf, true));
}
__device__ __forceinline__ float wave_sum(float v) {
#pragma unroll
    for (int o = 1; o < 64; o <<= 1) v += __shfl_xor(v, o);
    return v;
}

namespace pg8 {
constexpr int BM = 256, BK = 64, HALF = 128, HTB = HALF * BK * 2, STAGE_BYTES = 8 * HTB, NXCD = 8, WGM = 8;
__host__ __device__ __forceinline__ int lds_byte(int r, int c) { const int st = (r >> 4) * 2 + (c >> 5), rr = r & 15, cc = c & 31, ob = rr * 64 + cc * 2; return st * 1024 + (ob ^ (((ob >> 9) & 1) << 5)); }
__host__ __device__ __forceinline__ void stage_rc(int b, int& R, int& C) { const int st = b / 1024, sb = b % 1024, swz = sb ^ (((sb >> 9) & 1) << 5); R = (st >> 1) * 16 + swz / 64; C = (st & 1) * 32 + (swz % 64) / 2; }
__host__ __device__ __forceinline__ int perm32(int rho) { const int n = rho >> 4, i = rho & 15; return 8 * (i >> 2) + 4 * n + (i & 3); }
struct Unit { int pm, pn, half; };
struct Gemm { const bf16_t* A; const bf16_t* Bt; int M, N, K; };
struct StaticOrder {
    int nM, nN, nwg, G, c;
    __host__ __device__ void init(int M_, int N_, int G_, int c_) { nM = M_ / BM; nN = N_ / BM; nwg = nM * nN; G = G_; c = c_; }
    __host__ __device__ bool next(int i, Unit& u) const {
        const long L = (long)i * G + c; if (L >= nwg) return false;
        int wgid = (int)L; { const int q = nwg / NXCD, r = nwg % NXCD, xcd = wgid % NXCD, off = wgid / NXCD; wgid = (xcd < r ? xcd * (q + 1) : r * (q + 1) + (xcd - r) * q) + off; }
        const int nig = WGM * nN, gid = wgid / nig, fm = gid * WGM, gsz = (nM - fm) < WGM ? (nM - fm) : WGM;
        u.pm = fm + ((wgid % nig) % gsz); u.pn = (wgid % nig) / gsz; u.half = 0; return true;
    }
};
struct HalfTailOrder {
    StaticOrder so; int nfull, rem;
    __host__ __device__ void init(int M_, int N_, int G_, int c_) { so.init(M_, N_, G_, c_); nfull = so.nwg / G_; rem = so.nwg - nfull * G_; }
    __host__ __device__ bool next(int i, Unit& u) const {
        if (rem == 0 || 2 * rem > so.G || (rem % 8) != 0 || (so.G % 8) != 0) return so.next(i, u);
        if (i < nfull) return so.next(i, u);
        if (i > nfull || (so.c >> 3) >= 2 * (rem / 8)) return false;
        StaticOrder t = so; t.c = ((so.c >> 3) >> 1) * 8 + (so.c & 7);
        if (!t.next(nfull, u)) return false;
        u.half = 1 + ((so.c >> 3) & 1); return true;
    }
};
struct EpiBf16 {
    static constexpr bool CONV = false;
    static constexpr bool PERM = true;
    static constexpr bool AFTER_DRAIN = false;
    bf16_t* O; int ldc; const float* rowscale;
    __device__ __forceinline__ void operator()(const f32x4 (&acc)[2][2][4][2], const Unit& u, int wr, int wc, int fr, int fq) const {
        const int row0 = u.pm * BM + wr * 64 + fr, col0 = u.pn * BM + wc * 32 + 8 * fq;
        float rsv[2][4];
#pragma unroll
        for (int ai = 0; ai < 2; ++ai)
#pragma unroll
            for (int m = 0; m < 4; ++m) rsv[ai][m] = rowscale[row0 + ai * HALF + m * 16];
#pragma unroll
        for (int ai = 0; ai < 2; ++ai)
#pragma unroll
            for (int m = 0; m < 4; ++m) { const int row = row0 + ai * HALF + m * 16; const float rsc = rsv[ai][m]; bf16_t* rowp = O + (size_t)row * ldc + col0;
#pragma unroll
                for (int bj = 0; bj < 2; ++bj) { const f32x4 v0 = acc[ai][bj][m][0] * rsc, v1 = acc[ai][bj][m][1] * rsc;
                    u32x4 w; w.x = cvt_pk_bf16(v0[0], v0[1]); w.y = cvt_pk_bf16(v0[2], v0[3]); w.z = cvt_pk_bf16(v1[0], v1[1]); w.w = cvt_pk_bf16(v1[2], v1[3]); *(u32x4*)(rowp + bj * HALF) = w; } }
    }
};
struct EpiF32 {
    static constexpr bool CONV = false;
    static constexpr bool PERM = false;
    static constexpr bool AFTER_DRAIN = false;
    float* O; int ldc;
    __device__ __forceinline__ void operator()(const f32x4 (&acc)[2][2][4][2], const Unit& u, int wr, int wc, int fr, int fq) const {
        const int row0 = u.pm * BM + wr * 64 + fr, col0 = u.pn * BM + wc * 32 + 4 * fq;
#pragma unroll
        for (int ai = 0; ai < 2; ++ai)
#pragma unroll
            for (int m = 0; m < 4; ++m) { float* rowp = O + (size_t)(row0 + ai * HALF + m * 16) * ldc + col0;
#pragma unroll
                for (int bj = 0; bj < 2; ++bj)
#pragma unroll
                    for (int n = 0; n < 2; ++n) *(f32x4*)(rowp + bj * HALF + n * 16) = acc[ai][bj][m][n]; }
    }
};
struct EpiConvGate {
    static constexpr bool CONV = true;
    static constexpr bool PERM = true;
    static constexpr bool AFTER_DRAIN = false;
    bf16_t* G; bf16_t* E; const float* cw; const float* cb; const float* rowscale;
    static constexpr int CBUF_OFF = 131072, CBUF_BYTES = 8192;
    __device__ __forceinline__ void prefetch(LAS unsigned char* lds, const Unit& u, int buf, int tid, int wid) const {
        const int rowbase = u.pm * BM + (u.half == 2 ? HALF : 0);
#pragma unroll
        for (int it = 0; it < 4; ++it) {
            const int f = it * 512 + tid;
            const float* gp;
            if (f < 1024) { const int sgm = f >> 7, c = f & 127; const float* sb = (sgm & 3) == 3 ? cb : cw + (sgm & 3) * NUP; gp = sb + (sgm >> 2) * DFF + u.pn * 128 + c; }
            else gp = rowscale + (size_t)rowbase * 4 + (f - 1024);
            __builtin_amdgcn_global_load_lds((const unsigned*)gp, (LAS unsigned*)(lds + CBUF_OFF + buf * CBUF_BYTES + (it * 512 + wid * 64) * 4), 4, 0, 0);
        }
    }
    __device__ __forceinline__ void operator()(const f32x4 (&acc)[2][2][4][2], const Unit& u, int wr, int wc, int fr, int fq, LAS unsigned char* lds, int buf) const {
        const LAS float* CB = (const LAS float*)(lds + CBUF_OFF + buf * CBUF_BYTES);
        u32x2 pk0[2][4];
        float rsv[2][4];
#pragma unroll
        for (int ai = 0; ai < 2; ++ai)
#pragma unroll
            for (int m = 0; m < 4; ++m) { const f32x4 p = *(const LAS f32x4*)(CB + 1024 + 4 * ((u.half ? 0 : ai * HALF) + wr * 64 + 16 * m + fr));
                rsv[ai][m] = __builtin_amdgcn_rsqf(((p.x + p.y) + (p.z + p.w)) * (1.0f / 1024.0f) + RMS_EPS); }
#pragma unroll
        for (int n = 0; n < 2; ++n) {
            const int ch = u.pn * 128 + wc * 32 + 8 * fq + 4 * n;
            const int cc = wc * 32 + 8 * fq + 4 * n;
            const f32x4 wg0 = *(const LAS f32x4*)(CB + cc), wg1 = *(const LAS f32x4*)(CB + 128 + cc), wg2 = *(const LAS f32x4*)(CB + 256 + cc), bg = *(const LAS f32x4*)(CB + 384 + cc);
            const f32x4 wv0 = *(const LAS f32x4*)(CB + 512 + cc), wv1 = *(const LAS f32x4*)(CB + 640 + cc), wv2 = *(const LAS f32x4*)(CB + 768 + cc), bv = *(const LAS f32x4*)(CB + 896 + cc);
#pragma unroll
            for (int ai = 0; ai < 2; ++ai) {
                if (ai == 1 && u.half) continue;
                const int rb = u.pm * BM + (u.half == 2 ? HALF : 0) + ai * HALF + wr * 64, blk = rb >> 6;
                f32x4 pg = (f32x4){0.f, 0.f, 0.f, 0.f}, pv = pg;
#pragma unroll
                for (int m = 0; m < 4; ++m) {
                    const float rsc = rsv[ai][m];
                    const f32x4 g = acc[ai][0][m][n] * rsc, v = acc[ai][1][m][n] * rsc;
                    if (m == 0 && fr < 2) { bf16_t* e = E + ((size_t)(blk * 4 + fr) * 2) * DFF + ch; *(u32x2*)e = (u32x2){cvt_pk_bf16(g[0], g[1]), cvt_pk_bf16(g[2], g[3])}; *(u32x2*)(e + DFF) = (u32x2){cvt_pk_bf16(v[0], v[1]), cvt_pk_bf16(v[2], v[3])}; }
                    if (m == 3 && fr >= 14) { bf16_t* e = E + ((size_t)(blk * 4 + fr - 12) * 2) * DFF + ch; *(u32x2*)e = (u32x2){cvt_pk_bf16(g[0], g[1]), cvt_pk_bf16(g[2], g[3])}; *(u32x2*)(e + DFF) = (u32x2){cvt_pk_bf16(v[0], v[1]), cvt_pk_bf16(v[2], v[3])}; }
                    f32x4 sg1, sg2, sv1, sv2;
#pragma unroll
                    for (int j = 0; j < 4; ++j) { sg1[j] = fr == 15 ? pg[j] : g[j]; sg2[j] = fr >= 14 ? pg[j] : g[j]; sv1[j] = fr == 15 ? pv[j] : v[j]; sv2[j] = fr >= 14 ? pv[j] : v[j]; }
                    f32x4 g1, g2, v1, v2;
#pragma unroll
                    for (int j = 0; j < 4; ++j) { g1[j] = dpp_rot<0x121>(sg1[j]); g2[j] = dpp_rot<0x122>(sg2[j]); v1[j] = dpp_rot<0x121>(sv1[j]); v2[j] = dpp_rot<0x122>(sv2[j]); }
                    const f32x4 cgv = wg0 * g2 + wg1 * g1 + wg2 * g + bg;
                    const f32x4 cvv = wv0 * v2 + wv1 * v1 + wv2 * v + bv;
                    const f32x4 o = gelu_tanh4(cgv) * cvv;
                    u32x2 w; w.x = cvt_pk_bf16(o[0], o[1]); w.y = cvt_pk_bf16(o[2], o[3]);
                    if (n == 0) pk0[ai][m] = w;
                    else *(u32x4*)(G + (size_t)(rb + 16 * m + fr) * DFF + ch - 4) = (u32x4){pk0[ai][m].x, pk0[ai][m].y, w.x, w.y};
                    pg = g; pv = v;
                }
            }
        }
    }
};

struct PanelRms {
    unsigned* xbuf;
    unsigned* cnt;
    __device__ __forceinline__ void run(const f32x4 (&v)[2][2][4][2], const Unit& u, int wr, int wc, int fr, int fq, LAS unsigned char* lds, int wid, int lane) const {
        LAS float* P = (LAS float*)lds;
        LAS float* S = (LAS float*)(lds + 8192);
#pragma unroll
        for (int ai = 0; ai < 2; ++ai)
#pragma unroll
            for (int m = 0; m < 4; ++m) {
                float s = 0.f;
#pragma unroll
                for (int bj = 0; bj < 2; ++bj)
#pragma unroll
                    for (int n = 0; n < 2; ++n) { const f32x4 x = v[ai][bj][m][n]; s += (x[0] * x[0] + x[1] * x[1]) + (x[2] * x[2] + x[3] * x[3]); }
                s += __shfl_xor(s, 16); s += __shfl_xor(s, 32);
                if (fq == 0) P[(ai * HALF + wr * 64 + m * 16 + fr) * 4 + wc] = s;
            }
        asm volatile("s_waitcnt lgkmcnt(0)" ::: "memory"); __builtin_amdgcn_s_barrier(); asm volatile("" ::: "memory");
        const int row = wid * 32 + (lane & 31);
        if (lane < 32) {
            const f32x4 p = *(const LAS f32x4*)(P + row * 4);
            __hip_atomic_store(xbuf + (size_t)(u.pm * BM + row) * 4 + u.pn, __float_as_uint((p.x + p.y) + (p.z + p.w)), __ATOMIC_RELAXED, __HIP_MEMORY_SCOPE_AGENT);
        }
        asm volatile("s_waitcnt vmcnt(0)" ::: "memory");
        if (lane == 0) __hip_atomic_fetch_add(cnt + 64 * u.pm, 1u, __ATOMIC_RELAXED, __HIP_MEMORY_SCOPE_AGENT);
        if (wid == 0) {
            unsigned sp = 0;
            while ((unsigned)__builtin_amdgcn_readfirstlane(__hip_atomic_load(cnt + 64 * u.pm, __ATOMIC_RELAXED, __HIP_MEMORY_SCOPE_AGENT)) < 32u) { __builtin_amdgcn_s_sleep(2); if (++sp > (1u << 22)) break; }
        }
        asm volatile("s_waitcnt vmcnt(0) lgkmcnt(0)" ::: "memory"); __builtin_amdgcn_s_barrier(); asm volatile("" ::: "memory");
        if (lane < 32) {
            const unsigned* slot = xbuf + (size_t)(u.pm * BM + row) * 4; float tot = 0.f;
#pragma unroll
            for (int t = 0; t < 4; ++t) tot += __uint_as_float(__hip_atomic_load(slot + t, __ATOMIC_RELAXED, __HIP_MEMORY_SCOPE_AGENT));
            S[row] = 1.0f / sqrtf(tot * (1.0f / 1024.0f) + RMS_EPS);
        }
        asm volatile("s_waitcnt lgkmcnt(0)" ::: "memory"); __builtin_amdgcn_s_barrier(); asm volatile("" ::: "memory");
    }
};
__device__ __forceinline__ void publish_row_ssq(const f32x4 (&v)[2][2][4][2], const Unit& u, int wr, int wc, int fr, int fq, LAS unsigned char* lds, int wid, int lane, float* pbuf) {
    LAS float* P = (LAS float*)lds;
#pragma unroll
    for (int ai = 0; ai < 2; ++ai)
#pragma unroll
        for (int m = 0; m < 4; ++m) {
            float s = 0.f;
#pragma unroll
            for (int bj = 0; bj < 2; ++bj)
#pragma unroll
                for (int n = 0; n < 2; ++n) { const f32x4 x = v[ai][bj][m][n]; s += (x[0] * x[0] + x[1] * x[1]) + (x[2] * x[2] + x[3] * x[3]); }
            s += __shfl_xor(s, 16); s += __shfl_xor(s, 32);
            if (fq == 0) P[(ai * HALF + wr * 64 + m * 16 + fr) * 4 + wc] = s;
        }
    asm volatile("s_waitcnt lgkmcnt(0)" ::: "memory"); __builtin_amdgcn_s_barrier(); asm volatile("" ::: "memory");
    const int row = wid * 32 + (lane & 31);
    if (lane < 32) { const f32x4 p = *(const LAS f32x4*)(P + row * 4); pbuf[(size_t)(u.pm * BM + row) * 4 + u.pn] = (p.x + p.y) + (p.z + p.w); }
}
struct EpiRmsResRms {
    static constexpr bool CONV = false;
    static constexpr bool PERM = true;
    static constexpr bool AFTER_DRAIN = true;
    const bf16_t* xb; bf16_t* x1b; float* rs2; const float* g1; PanelRms st1, st2;
    __device__ __forceinline__ void fused(f32x4 (&acc)[2][2][4][2], const Unit& u, int wr, int wc, int fr, int fq, LAS unsigned char* lds, int wid, int lane) const {
        const LAS float* S = (const LAS float*)(lds + 8192);
        const int col0 = u.pn * BM + wc * 32 + 8 * fq;
        u32x4 pre[2][4][2];
#pragma unroll
        for (int ai = 0; ai < 2; ++ai)
#pragma unroll
            for (int m = 0; m < 4; ++m) { const size_t off = (size_t)(u.pm * BM + ai * HALF + wr * 64 + m * 16 + fr) * DM + col0;
#pragma unroll
                for (int bj = 0; bj < 2; ++bj) pre[ai][m][bj] = *(const u32x4*)(xb + off + bj * HALF); }
        st1.run(acc, u, wr, wc, fr, fq, lds, wid, lane);
        f32x4 gv[2][2];
#pragma unroll
        for (int bj = 0; bj < 2; ++bj)
#pragma unroll
            for (int n = 0; n < 2; ++n) gv[bj][n] = *(const f32x4*)(g1 + col0 + bj * HALF + 4 * n);
#pragma unroll
        for (int ai = 0; ai < 2; ++ai)
#pragma unroll
            for (int m = 0; m < 4; ++m) { const int r = ai * HALF + wr * 64 + m * 16 + fr; const float rs = S[r]; const size_t off = (size_t)(u.pm * BM + r) * DM + col0;
#pragma unroll
                for (int bj = 0; bj < 2; ++bj) { const u32x4 p = pre[ai][m][bj];
                    const f32x4 x0 = (f32x4){bf_lo(p.x), bf_hi(p.x), bf_lo(p.y), bf_hi(p.y)} + acc[ai][bj][m][0] * rs * gv[bj][0];
                    const f32x4 x1 = (f32x4){bf_lo(p.z), bf_hi(p.z), bf_lo(p.w), bf_hi(p.w)} + acc[ai][bj][m][1] * rs * gv[bj][1];
                    acc[ai][bj][m][0] = x0; acc[ai][bj][m][1] = x1;
                    u32x4 w; w.x = cvt_pk_bf16(x0[0], x0[1]); w.y = cvt_pk_bf16(x0[2], x0[3]); w.z = cvt_pk_bf16(x1[0], x1[1]); w.w = cvt_pk_bf16(x1[2], x1[3]);
                    *(u32x4*)(x1b + off + bj * HALF) = w; }
                if (m & 1) asm volatile("" ::: "memory"); }
        publish_row_ssq(acc, u, wr, wc, fr, fq, lds, wid, lane, rs2);
    }
};
struct EpiRmsRes {
    static constexpr bool CONV = false;
    static constexpr bool PERM = true;
    static constexpr bool AFTER_DRAIN = true;
    const bf16_t* x1b; float* out; const float* g; PanelRms st;
    __device__ __forceinline__ void fused(f32x4 (&acc)[2][2][4][2], const Unit& u, int wr, int wc, int fr, int fq, LAS unsigned char* lds, int wid, int lane) const {
        const LAS float* S = (const LAS float*)(lds + 8192);
        const int col0 = u.pn * BM + wc * 32 + 8 * fq;
        u32x4 pre[2][4][2];
#pragma unroll
        for (int ai = 0; ai < 2; ++ai)
#pragma unroll
            for (int m = 0; m < 4; ++m) { const size_t off = (size_t)(u.pm * BM + ai * HALF + wr * 64 + m * 16 + fr) * DM + col0;
#pragma unroll
                for (int bj = 0; bj < 2; ++bj) pre[ai][m][bj] = *(const u32x4*)(x1b + off + bj * HALF); }
        st.run(acc, u, wr, wc, fr, fq, lds, wid, lane);
        f32x4 gv[2][2];
#pragma unroll
        for (int bj = 0; bj < 2; ++bj)
#pragma unroll
            for (int n = 0; n < 2; ++n) gv[bj][n] = *(const f32x4*)(g + col0 + bj * HALF + 4 * n);
#pragma unroll
        for (int ai = 0; ai < 2; ++ai)
#pragma unroll
            for (int m = 0; m < 4; ++m) { const int r = ai * HALF + wr * 64 + m * 16 + fr; const float rs = S[r]; const size_t off = (size_t)(u.pm * BM + r) * DM + col0;
#pragma unroll
                for (int bj = 0; bj < 2; ++bj) { const u32x4 p = pre[ai][m][bj];
                    *(f32x4*)(out + off + bj * HALF) = (f32x4){bf_lo(p.x), bf_hi(p.x), bf_lo(p.y), bf_hi(p.y)} + acc[ai][bj][m][0] * rs * gv[bj][0];
                    *(f32x4*)(out + off + bj * HALF + 4) = (f32x4){bf_lo(p.z), bf_hi(p.z), bf_lo(p.w), bf_hi(p.w)} + acc[ai][bj][m][1] * rs * gv[bj][1]; }
                if (m & 1) asm volatile("" ::: "memory"); }
    }
};

template <class Epi, class Sched, bool ALIGN_EPI, bool SP2>
__device__ __forceinline__ void gemm_phase(LAS unsigned char* lds, const Gemm g, const Sched& S, const Epi& E) {
    const int tid = threadIdx.x, wid = __builtin_amdgcn_readfirstlane(tid >> 6), lane = tid & 63, wr = wid >> 2, wc = wid & 3, fr = lane & 15, fq = lane >> 4;
    const int K = g.K, nt = K / BK;
    unsigned voffA[2], voffB[2];
#pragma unroll
    for (int i = 0; i < 2; ++i) { int R, C; stage_rc(tid * 16 + i * 8192, R, C); const int Rb = Epi::PERM ? ((R & ~31) + perm32(R & 31)) : R; voffA[i] = (unsigned)(R * K + C) * 2u; voffB[i] = (unsigned)(Rb * K + C) * 2u; }
    const size_t kstep = (size_t)(BK * 2);
    const size_t hstep = (size_t)HALF * K * 2;
    const size_t tstep = 2 * hstep;
    const unsigned ldsw = (unsigned)wid * 1024u;
    const int aoff = lds_byte(wr * 64 + fr, fq * 8), boff = lds_byte(wc * 32 + fr, fq * 8);
#define PG8_SA(b, h) (((b) * 2 + (h)) * HTB)
#define PG8_SB(b, h) ((4 + (b) * 2 + (h)) * HTB)
#define PG8_STAGE(bufoff, gbase, voff) do { _Pragma("unroll") for (int _i = 0; _i < 2; ++_i) \
        __builtin_amdgcn_global_load_lds((const unsigned*)((const char*)(gbase) + (voff)[_i]), (LAS unsigned*)(lds + (bufoff) + ldsw + _i * 8192), 16, 0, 0); } while (0)
#define PG8_LDA(dst, b, h) do { _Pragma("unroll") for (int m = 0; m < 4; ++m) _Pragma("unroll") for (int k = 0; k < 2; ++k) dst[m][k] = *(const LAS bf16x8*)(lds + PG8_SA(b, h) + aoff + m * 2048 + k * 1024); } while (0)
#define PG8_LDB(dst, b, h) do { _Pragma("unroll") for (int n = 0; n < 2; ++n) _Pragma("unroll") for (int k = 0; k < 2; ++k) dst[n][k] = *(const LAS bf16x8*)(lds + PG8_SB(b, h) + boff + n * 2048 + k * 1024); } while (0)
#define PG8_MMA(ai, bj, At, Bt) do { __builtin_amdgcn_s_setprio(1); _Pragma("unroll") for (int m = 0; m < 4; ++m) _Pragma("unroll") for (int n = 0; n < 2; ++n) _Pragma("unroll") for (int k = 0; k < 2; ++k) \
        acc[ai][bj][m][n] = __builtin_amdgcn_mfma_f32_16x16x32_bf16(Bt[n][k], At[m][k], acc[ai][bj][m][n], 0, 0, 0); __builtin_amdgcn_s_setprio(0); } while (0)
#define PG8_WAIT_V(n) asm volatile("s_waitcnt vmcnt(" #n ")" ::: "memory")
#define PG8_WAIT_L(n) asm volatile("s_waitcnt lgkmcnt(" #n ")" ::: "memory")
#define PG8_BAR __builtin_amdgcn_s_barrier()
#define PG8_SCHED __builtin_amdgcn_sched_barrier(0)
    Unit cur, nxt; int ui = 0;
    if (!S.next(0, cur)) return;
    f32x4 acc[2][2][4][2];
#pragma unroll
    for (int a = 0; a < 2; ++a)
#pragma unroll
        for (int b = 0; b < 2; ++b)
#pragma unroll
            for (int m = 0; m < 4; ++m)
#pragma unroll
                for (int n = 0; n < 2; ++n) acc[a][b][m][n] = (f32x4){0.f, 0.f, 0.f, 0.f};
    bf16x8 At[4][2], B0[2][2], B1[2][2];
    const char* cA = (const char*)g.A + (size_t)cur.pm * tstep + (cur.half == 2 ? hstep : 0); const char* cB = (const char*)g.Bt + (size_t)cur.pn * tstep;
    if constexpr (Epi::CONV) E.prefetch(lds, cur, 0, tid, wid);
    if constexpr (SP2) {
        PG8_STAGE(PG8_SB(0, 0), cB, voffB); PG8_STAGE(PG8_SB(0, 1), cB + hstep, voffB); PG8_STAGE(PG8_SA(0, 0), cA, voffA); PG8_STAGE(PG8_SA(0, 1), cA + hstep, voffA);
        if (wr == 1) PG8_BAR;
        PG8_WAIT_V(2); PG8_BAR;
        PG8_STAGE(PG8_SB(1, 0), cB + kstep, voffB); PG8_STAGE(PG8_SA(1, 0), cA + kstep, voffA); PG8_STAGE(PG8_SB(1, 1), cB + hstep + kstep, voffB);
        PG8_WAIT_V(6); PG8_BAR;
    } else {
        PG8_STAGE(PG8_SB(0, 0), cB, voffB); PG8_STAGE(PG8_SA(0, 0), cA, voffA); PG8_STAGE(PG8_SB(0, 1), cB + hstep, voffB); PG8_STAGE(PG8_SA(0, 1), cA + hstep, voffA);
        if (wr == 1) PG8_BAR;
        PG8_WAIT_V(4); PG8_BAR;
        PG8_STAGE(PG8_SB(1, 0), cB + kstep, voffB); PG8_STAGE(PG8_SA(1, 0), cA + kstep, voffA); PG8_STAGE(PG8_SB(1, 1), cB + hstep + kstep, voffB);
        PG8_WAIT_V(6); PG8_BAR;
    }
    for (;;) {
        const bool has_next = S.next(ui + 1, nxt);
        const char* nA = has_next ? (const char*)g.A + (size_t)nxt.pm * tstep + (nxt.half == 2 ? hstep : 0) : cA; const char* nB = has_next ? (const char*)g.Bt + (size_t)nxt.pn * tstep : cB;
        for (int t = 0; t < nt; t += 2) {
            const bool last = (t == nt - 2);
            const char* a1 = cA + (size_t)(t + 1) * kstep;
            const char* a2 = last ? nA : cA + (size_t)(t + 2) * kstep; const char* b2 = last ? nB : cB + (size_t)(t + 2) * kstep;
            const char* a3 = a2 + kstep; const char* b3 = b2 + kstep;
            if constexpr (Epi::CONV) { if (last && has_next) E.prefetch(lds, nxt, (ui + 1) & 1, tid, wid); }
            if constexpr (SP2) {
            PG8_LDB(B0, 0, 0); PG8_LDB(B1, 0, 1); PG8_SCHED; PG8_LDA(At, 0, 0); PG8_STAGE(PG8_SA(1, 1), a1 + hstep, voffA);
            PG8_WAIT_V(8); PG8_WAIT_L(0); PG8_BAR; PG8_MMA(0, 0, At, B0); PG8_MMA(0, 1, At, B1); PG8_BAR; PG8_SCHED;
            if (!cur.half) PG8_LDA(At, 0, 1); PG8_STAGE(PG8_SB(0, 0), b2, voffB); PG8_STAGE(PG8_SB(0, 1), b2 + hstep, voffB); PG8_STAGE(PG8_SA(0, 0), a2, voffA);
            PG8_WAIT_V(8); PG8_WAIT_L(0); PG8_BAR; if (!cur.half) { PG8_MMA(1, 0, At, B0); PG8_MMA(1, 1, At, B1); } PG8_BAR; PG8_SCHED;
            PG8_LDB(B0, 1, 0); PG8_LDB(B1, 1, 1); PG8_SCHED; PG8_LDA(At, 1, 0); PG8_STAGE(PG8_SA(0, 1), a2 + hstep, voffA);
            PG8_WAIT_V(8); PG8_WAIT_L(0); PG8_BAR; PG8_MMA(0, 0, At, B0); PG8_MMA(0, 1, At, B1); PG8_BAR; PG8_SCHED;
            if (!cur.half) PG8_LDA(At, 1, 1); PG8_STAGE(PG8_SB(1, 0), b3, voffB); PG8_STAGE(PG8_SB(1, 1), b3 + hstep, voffB); PG8_STAGE(PG8_SA(1, 0), a3, voffA);
            PG8_WAIT_V(8); PG8_WAIT_L(0); PG8_BAR; if (!cur.half) { PG8_MMA(1, 0, At, B0); PG8_MMA(1, 1, At, B1); } PG8_BAR; PG8_SCHED;
            } else {
            PG8_LDB(B0, 0, 0); PG8_SCHED; PG8_LDA(At, 0, 0); PG8_STAGE(PG8_SA(1, 1), a1 + hstep, voffA);
            PG8_WAIT_L(8); PG8_BAR; PG8_WAIT_L(0); PG8_MMA(0, 0, At, B0); PG8_BAR; PG8_SCHED;
            PG8_LDB(B1, 0, 1); PG8_STAGE(PG8_SB(0, 0), b2, voffB);
            PG8_BAR; PG8_WAIT_L(0); PG8_MMA(0, 1, At, B1); PG8_BAR;
            PG8_LDA(At, 0, 1); PG8_STAGE(PG8_SA(0, 0), a2, voffA);
            PG8_BAR; PG8_WAIT_L(0); PG8_MMA(1, 0, At, B0); PG8_BAR; PG8_SCHED;
            PG8_STAGE(PG8_SB(0, 1), b2 + hstep, voffB);
            PG8_WAIT_V(6); PG8_BAR; PG8_MMA(1, 1, At, B1); PG8_BAR;
            PG8_LDB(B0, 1, 0); PG8_SCHED; PG8_LDA(At, 1, 0); PG8_STAGE(PG8_SA(0, 1), a2 + hstep, voffA);
            PG8_WAIT_L(8); PG8_BAR; PG8_WAIT_L(0); PG8_MMA(0, 0, At, B0); PG8_BAR; PG8_SCHED;
            PG8_LDB(B1, 1, 1); PG8_STAGE(PG8_SB(1, 0), b3, voffB);
            PG8_BAR; PG8_WAIT_L(0); PG8_MMA(0, 1, At, B1); PG8_BAR;
            PG8_LDA(At, 1, 1); PG8_STAGE(PG8_SA(1, 0), a3, voffA);
            PG8_BAR; PG8_WAIT_L(0); PG8_MMA(1, 0, At, B0); PG8_BAR; PG8_SCHED;
            PG8_STAGE(PG8_SB(1, 1), b3 + hstep, voffB);
            PG8_WAIT_V(6); PG8_BAR; PG8_MMA(1, 1, At, B1); PG8_BAR;
            }
        }
        if constexpr (ALIGN_EPI) { if (wr == 0) PG8_BAR; }
        if constexpr (Epi::CONV) E(acc, cur, wr, wc, fr, fq, lds, ui & 1);
        else if constexpr (!Epi::AFTER_DRAIN) E(acc, cur, wr, wc, fr, fq);
        if (!has_next) break;
#pragma unroll
        for (int a = 0; a < 2; ++a)
#pragma unroll
            for (int b = 0; b < 2; ++b)
#pragma unroll
                for (int m = 0; m < 4; ++m)
#pragma unroll
                    for (int n = 0; n < 2; ++n) acc[a][b][m][n] = (f32x4){0.f, 0.f, 0.f, 0.f};
        cur = nxt; cA = nA; cB = nB; ++ui;
        if constexpr (ALIGN_EPI) { if (wr == 1) PG8_BAR; }
    }
    PG8_WAIT_V(0);
    if constexpr (!ALIGN_EPI) { if (wr == 0) PG8_BAR; }
    PG8_BAR;
    if constexpr (Epi::AFTER_DRAIN) E.fused(acc, cur, wr, wc, fr, fq, lds, wid, lane);
#undef PG8_SA
#undef PG8_SB
#undef PG8_STAGE
#undef PG8_LDA
#undef PG8_LDB
#undef PG8_MMA
#undef PG8_WAIT_V
#undef PG8_WAIT_L
#undef PG8_BAR
#undef PG8_SCHED
}
}

template <bool PERMUP, bool WTHRU = false>
__device__ __forceinline__ void p0_transpose_item(const float* W, int K, int N, bf16_t* WT, LAS float* scr, int item, int lane, const float* kgain = nullptr) {
    const int nblk = N / 64, kb = item / nblk, nb = item % nblk, k0 = 64 * kb, n0 = 64 * nb;
    int d0 = n0;
    if (PERMUP) d0 = (n0 < DFF) ? (256 * (n0 / 128) + (n0 % 128)) : (256 * ((n0 - DFF) / 128) + 128 + ((n0 - DFF) % 128));
#pragma unroll 16
    for (int i = 0; i < 64; ++i) scr[i * 65 + lane] = W[(size_t)(k0 + i) * N + n0 + lane];
    asm volatile("s_waitcnt lgkmcnt(0)" ::: "memory");
    const int c = lane & 7;
    f32x4 ga = (f32x4){1.f, 1.f, 1.f, 1.f}, gb = ga;
    if (kgain) { ga = *(const f32x4*)(kgain + k0 + 8 * c); gb = *(const f32x4*)(kgain + k0 + 8 * c + 4); }
#pragma unroll
    for (int j = 0; j < 8; ++j) { const int n = (lane >> 3) + 8 * j; const LAS float* s = scr + (8 * c) * 65 + n;
        u32x4 o; o.x = cvt_pk_bf16(s[0 * 65] * ga.x, s[1 * 65] * ga.y); o.y = cvt_pk_bf16(s[2 * 65] * ga.z, s[3 * 65] * ga.w); o.z = cvt_pk_bf16(s[4 * 65] * gb.x, s[5 * 65] * gb.y); o.w = cvt_pk_bf16(s[6 * 65] * gb.z, s[7 * 65] * gb.w);
        bf16_t* dst = WT + (size_t)(d0 + n) * K + k0 + 8 * c;
        if (WTHRU) asm volatile("global_store_dwordx4 %0, %1, off sc1\n\ts_nop 1" :: "v"(dst), "v"(o) : "memory");
        else *(u32x4*)dst = o; }
    asm volatile("s_waitcnt lgkmcnt(0)" ::: "memory");
}
__device__ __forceinline__ void row_to_bf16_rs(const float* xrow, bf16_t* orow, float* rs_out, int lane) {
    const f32x4* xr = (const f32x4*)xrow + lane;
    f32x4 v[4]; float s = 0.f;
#pragma unroll
    for (int j = 0; j < 4; ++j) { v[j] = xr[64 * j]; s += (v[j].x * v[j].x + v[j].y * v[j].y) + (v[j].z * v[j].z + v[j].w * v[j].w); }
    const float rs = 1.0f / sqrtf(wave_sum(s) * (1.f / DM) + RMS_EPS);
    u32x2* o8 = (u32x2*)orow + lane;
#pragma unroll
    for (int j = 0; j < 4; ++j) { u32x2 w; w.x = cvt_pk_bf16(v[j].x, v[j].y); w.y = cvt_pk_bf16(v[j].z, v[j].w); o8[64 * j] = w; }
    if (lane == 0) *rs_out = rs;
}

constexpr int KSTR = 136, VSTR = 216, KROWS = 208;
constexpr int ATT_VT_OFF = KROWS * KSTR * 2;
constexpr int ATT_SS_OFF = ATT_VT_OFF + 128 * VSTR * 2;
__device__ __forceinline__ void attn_unit(LAS unsigned char* lds, const bf16_t* PROJ, bf16_t* MERGED, const float* sinks, const float* g_attn, int u, int tid, int wid, int lane) {
    const int b = u >> 5, qb = u & 31;
    const int kb0 = 64 * qb - 144;
    LAS bf16_t* Ks = (LAS bf16_t*)lds;
    LAS bf16_t* Vt = (LAS bf16_t*)(lds + ATT_VT_OFF);
    LAS float* SS = (LAS float*)(lds + ATT_SS_OFF);
    const bf16_t* base = PROJ + (size_t)b * SEQ * INW;
    for (int task = tid; task < KROWS * 16; task += 512) {
        const int kr = task >> 4, cc = task & 15, tok = kb0 + kr;
        u32x4 v = *(const u32x4*)(base + (size_t)(tok < 0 ? 0 : tok) * INW + KOFF + 8 * cc);
        if (tok < 0) v = (u32x4){0u, 0u, 0u, 0u};
        *(LAS u32x4*)(Ks + kr * KSTR + 8 * cc) = v;
    }
    for (int task = tid; task < (KROWS / 2) * 16; task += 512) {
        const int kp = task % (KROWS / 2), dc = task / (KROWS / 2), tok = kb0 + 2 * kp;
        const int tokc = tok < 0 ? 0 : tok;
        u32x4 a0 = *(const u32x4*)(base + (size_t)tokc * INW + VOFF + 8 * dc), a1 = *(const u32x4*)(base + (size_t)(tokc + 1) * INW + VOFF + 8 * dc);
        if (tok < 0) { a0 = (u32x4){0u, 0u, 0u, 0u}; a1 = a0; }
#pragma unroll
        for (int e = 0; e < 8; ++e) {
            const unsigned w0 = a0[e >> 1], w1 = a1[e >> 1];
            const unsigned lo = (e & 1) ? (w0 >> 16) : (w0 & 0xffffu), hi = (e & 1) ? (w1 & 0xffff0000u) : (w1 << 16);
            *(LAS unsigned*)(Vt + (8 * dc + e) * VSTR + 2 * kp) = lo | hi;
        }
    }
    __syncthreads();
    const int h = wid, kvh = h >> 2, qq = lane & 15, g = lane >> 4;
    const float slope2 = fast_exp2(-(float)(h + 1)) * LOG2E, sink2 = sinks[h] * LOG2E;
    f32x4 O[4][4];
#pragma unroll
    for (int i = 0; i < 4; ++i) {
        const int tq = 64 * qb + 16 * i + qq;
        const bf16_t* qp = base + (size_t)tq * INW + h * 64 + 8 * g;
        const bf16x8 qf0 = *(const bf16x8*)qp, qf1 = *(const bf16x8*)(qp + 32);
        f32x4 S[9];
#pragma unroll
        for (int jb = 0; jb < 9; ++jb) {
            const LAS bf16_t* kp = Ks + (16 * i + 16 + 16 * jb + qq) * KSTR + kvh * 64 + 8 * g;
            const bf16x8 k0 = *(const LAS bf16x8*)kp, k1 = *(const LAS bf16x8*)(kp + 32);
            f32x4 s = (f32x4){0.f, 0.f, 0.f, 0.f};
            s = __builtin_amdgcn_mfma_f32_16x16x32_bf16(k0, qf0, s, 0, 0, 0);
            s = __builtin_amdgcn_mfma_f32_16x16x32_bf16(k1, qf1, s, 0, 0, 0);
            S[jb] = s;
        }
        float mx = sink2;
#pragma unroll
        for (int jb = 0; jb < 9; ++jb)
#pragma unroll
            for (int r = 0; r < 4; ++r) {
                const int kk = 4 * g + r, dist = 128 - 16 * jb + qq - kk, ktok = 64 * qb + 16 * i - 128 + 16 * jb + kk;
                const bool valid = (dist >= 0) && (dist < 128) && (ktok >= 0);
                float l = S[jb][r] * (0.125f * LOG2E) - slope2 * (float)dist;
                l = valid ? l : -INFINITY;
                S[jb][r] = l; mx = fmaxf(mx, l);
            }
        mx = fmaxf(mx, __shfl_xor(mx, 16)); mx = fmaxf(mx, __shfl_xor(mx, 32));
        float den = 0.f;
#pragma unroll
        for (int jb = 0; jb < 9; ++jb)
#pragma unroll
            for (int r = 0; r < 4; ++r) { const float p = fast_exp2(S[jb][r] - mx); den += p; S[jb][r] = p; }
        den += __shfl_xor(den, 16); den += __shfl_xor(den, 32);
        den += fast_exp2(sink2 - mx);
        const float inv = fast_rcp(den);
#pragma unroll
        for (int db = 0; db < 4; ++db) O[i][db] = (f32x4){0.f, 0.f, 0.f, 0.f};
#pragma unroll
        for (int ks2 = 0; ks2 < 5; ++ks2) {
            u32x4 pw;
            if (ks2 == 0) { pw.x = 0u; pw.y = 0u; } else { pw.x = cvt_pk_bf16(S[2 * ks2 - 1][0], S[2 * ks2 - 1][1]); pw.y = cvt_pk_bf16(S[2 * ks2 - 1][2], S[2 * ks2 - 1][3]); }
            pw.z = cvt_pk_bf16(S[2 * ks2][0], S[2 * ks2][1]); pw.w = cvt_pk_bf16(S[2 * ks2][2], S[2 * ks2][3]);
            const bf16x8 pf = __builtin_bit_cast(bf16x8, pw);
#pragma unroll
            for (int db = 0; db < 4; ++db) {
                const LAS bf16_t* vp = Vt + (kvh * 64 + 16 * (qq >> 2) + 4 * db + (qq & 3)) * VSTR + 16 * i + 32 * ks2 + 4 * g;
                const u32x2 lo = *(const LAS u32x2*)vp, hi = *(const LAS u32x2*)(vp + 16);
                const u32x4 vw = (u32x4){lo.x, lo.y, hi.x, hi.y};
                O[i][db] = __builtin_amdgcn_mfma_f32_16x16x32_bf16(__builtin_bit_cast(bf16x8, vw), pf, O[i][db], 0, 0, 0);
            }
        }
        float ssq = 0.f;
#pragma unroll
        for (int db = 0; db < 4; ++db) { O[i][db] = O[i][db] * inv; const f32x4 o = O[i][db]; ssq += (o.x * o.x + o.y * o.y) + (o.z * o.z + o.w * o.w); }
        ssq += __shfl_xor(ssq, 16); ssq += __shfl_xor(ssq, 32);
        if (g == 0) SS[(16 * i + qq) * 8 + h] = ssq;
    }
    __syncthreads();
#pragma unroll
    for (int i = 0; i < 4; ++i) {
        const f32x4 s0 = *(const LAS f32x4*)(SS + (16 * i + qq) * 8), s1 = *(const LAS f32x4*)(SS + (16 * i + qq) * 8 + 4);
        const float tot = (s0.x + s0.y) + (s0.z + s0.w) + (s1.x + s1.y) + (s1.z + s1.w);
        const float rs = __builtin_amdgcn_rsqf(tot * (1.f / 512.f) + RMS_EPS);
        bf16_t* orow = MERGED + (size_t)(b * SEQ + 64 * qb + 16 * i + qq) * DM + h * 64 + 16 * g;
        unsigned pk[8];
#pragma unroll
        for (int db = 0; db < 4; ++db) {
            const f32x4 gg = *(const f32x4*)(g_attn + h * 64 + 16 * g + 4 * db); const f32x4 o = O[i][db];
            pk[2 * db] = cvt_pk_bf16(o.x * rs * gg.x, o.y * rs * gg.y); pk[2 * db + 1] = cvt_pk_bf16(o.z * rs * gg.z, o.w * rs * gg.w);
        }
        *(u32x4*)orow = (u32x4){pk[0], pk[1], pk[2], pk[3]}; *(u32x4*)(orow + 8) = (u32x4){pk[4], pk[5], pk[6], pk[7]};
    }
    __syncthreads();
}

__device__ __forceinline__ void lru_unit(LAS unsigned char* lds, const bf16_t* PROJ, const bf16_t* WaT, const bf16_t* WxT, const float* convw, const float* convb, const float* ba, const float* bx, const float* sp,
                                         float* SUMM, unsigned* FLAG, const float* g_lru, bf16_t* MERGED, int u, int tid, int wid, int lane) {
    const int b = u >> 5, c = u & 31, hd = wid, fr = lane & 15, g = lane >> 4;
    constexpr int HSTR = 520;
    LAS bf16_t* HLs = (LAS bf16_t*)lds; LAS bf16_t* ACs = (LAS bf16_t*)(lds + 64 * HSTR * 2);
    LAS float* C = (LAS float*)(lds + 2 * 64 * HSTR * 2);
    LAS float* Hs = C + 4096;
    C[tid] = convw[tid]; C[512 + tid] = convw[512 + tid]; C[1024 + tid] = convw[1024 + tid]; C[1536 + tid] = convw[1536 + tid];
    C[2048 + tid] = convb[tid]; C[2560 + tid] = ba[tid]; C[3072 + tid] = bx[tid]; C[3584 + tid] = sp[tid];
    bf16x8 wa[4][2], wx[4][2];
#pragma unroll
    for (int ob = 0; ob < 4; ++ob)
#pragma unroll
        for (int ks = 0; ks < 2; ++ks) {
            const size_t off = (size_t)(hd * 64 + 16 * (fr >> 2) + 4 * ob + (fr & 3)) * 64 + 16 * g + 8 * ks;
            wa[ob][ks] = *(const bf16x8*)(WaT + off); wx[ob][ks] = *(const bf16x8*)(WxT + off);
        }
    __syncthreads();
    f32x4 cH[4], cA[4];
#pragma unroll
    for (int ob = 0; ob < 4; ++ob) { cH[ob] = (f32x4){0.f, 0.f, 0.f, 0.f}; cA[ob] = (f32x4){1.f, 1.f, 1.f, 1.f}; }
    const int chb = hd * 64 + 16 * g;
    const bf16_t* lxb = PROJ + (size_t)b * SEQ * INW + LXOFF + chb;
#pragma unroll 1
    for (int tb = 0; tb < 4; ++tb) {
        const int t = 64 * c + 16 * tb + fr;
        u32x4 raw[4][2];
#pragma unroll
        for (int k = 0; k < 4; ++k) {
            const int tt = t - 3 + k, ttc = tt < 0 ? 0 : tt;
            raw[k][0] = *(const u32x4*)(lxb + (size_t)ttc * INW); raw[k][1] = *(const u32x4*)(lxb + (size_t)ttc * INW + 8);
            if (tt < 0) { raw[k][0] = (u32x4){0u, 0u, 0u, 0u}; raw[k][1] = raw[k][0]; }
        }
        float xc[16];
#pragma unroll
        for (int q = 0; q < 4; ++q) {
            f32x4 a = *(const LAS f32x4*)(C + 2048 + chb + 4 * q);
#pragma unroll
            for (int k = 0; k < 4; ++k) {
                const f32x4 w = *(const LAS f32x4*)(C + k * 512 + chb + 4 * q);
                const unsigned r0 = raw[k][q >> 1][2 * (q & 1)], r1 = raw[k][q >> 1][2 * (q & 1) + 1];
                a = a + w * (f32x4){bf_lo(r0), bf_hi(r0), bf_lo(r1), bf_hi(r1)};
            }
            xc[4 * q] = a.x; xc[4 * q + 1] = a.y; xc[4 * q + 2] = a.z; xc[4 * q + 3] = a.w;
        }
        bf16x8 xf[2];
#pragma unroll
        for (int ks = 0; ks < 2; ++ks) {
            u32x4 w; w.x = cvt_pk_bf16(xc[8 * ks], xc[8 * ks + 1]); w.y = cvt_pk_bf16(xc[8 * ks + 2], xc[8 * ks + 3]);
            w.z = cvt_pk_bf16(xc[8 * ks + 4], xc[8 * ks + 5]); w.w = cvt_pk_bf16(xc[8 * ks + 6], xc[8 * ks + 7]);
            xf[ks] = __builtin_bit_cast(bf16x8, w);
        }
        const size_t row = (size_t)b * SEQ + t;
        unsigned hp[8], ap[8];
#pragma unroll
        for (int ob = 0; ob < 4; ++ob) {
            f32x4 R = (f32x4){0.f, 0.f, 0.f, 0.f}, I = R;
            R = __builtin_amdgcn_mfma_f32_16x16x32_bf16(wa[ob][0], xf[0], R, 0, 0, 0); R = __builtin_amdgcn_mfma_f32_16x16x32_bf16(wa[ob][1], xf[1], R, 0, 0, 0);
            I = __builtin_amdgcn_mfma_f32_16x16x32_bf16(wx[ob][0], xf[0], I, 0, 0, 0); I = __builtin_amdgcn_mfma_f32_16x16x32_bf16(wx[ob][1], xf[1], I, 0, 0, 0);
            const f32x4 bav = *(const LAS f32x4*)(C + 2560 + chb + 4 * ob), bxv = *(const LAS f32x4*)(C + 3072 + chb + 4 * ob), spv = *(const LAS f32x4*)(C + 3584 + chb + 4 * ob);
            float hl[4], ac[4];
            f32x4 av4, uv4;
            {
                const f32x4 tr = (R + bav) * (-LOG2E), ti = (I + bxv) * (-LOG2E);
                f32x4 er, ei; er.x = fast_exp2(tr.x); er.y = fast_exp2(tr.y); er.z = fast_exp2(tr.z); er.w = fast_exp2(tr.w);
                ei.x = fast_exp2(ti.x); ei.y = fast_exp2(ti.y); ei.z = fast_exp2(ti.z); ei.w = fast_exp2(ti.w);
                const f32x4 dr = er + 1.0f, di = ei + 1.0f;
                f32x4 rg, ig; rg.x = fast_rcp(dr.x); rg.y = fast_rcp(dr.y); rg.z = fast_rcp(dr.z); rg.w = fast_rcp(dr.w);
                ig.x = fast_rcp(di.x); ig.y = fast_rcp(di.y); ig.z = fast_rcp(di.z); ig.w = fast_rcp(di.w);
                const f32x4 la2 = rg * spv * (-8.0f * LOG2E);
                f32x4 a4; a4.x = fast_exp2(la2.x); a4.y = fast_exp2(la2.y); a4.z = fast_exp2(la2.z); a4.w = fast_exp2(la2.w);
                f32x4 om = 1.0f - a4 * a4;
                om.x = fmaxf(om.x, 0.f); om.y = fmaxf(om.y, 0.f); om.z = fmaxf(om.z, 0.f); om.w = fmaxf(om.w, 0.f);
                f32x4 sq; sq.x = __builtin_amdgcn_sqrtf(om.x); sq.y = __builtin_amdgcn_sqrtf(om.y); sq.z = __builtin_amdgcn_sqrtf(om.z); sq.w = __builtin_amdgcn_sqrtf(om.w);
                const f32x4 xv = (f32x4){xc[4 * ob], xc[4 * ob + 1], xc[4 * ob + 2], xc[4 * ob + 3]};
                av4 = a4; uv4 = sq * ig * xv;
            }
#pragma unroll
            for (int r = 0; r < 4; ++r) {
                float a = av4[r], uu = uv4[r];
                { const float as = dpp_keep<0x111>(1.0f, a), us = dpp_zf<0x111>(uu); uu = uu + a * us; a = a * as; }
                { const float as = dpp_keep<0x112>(1.0f, a), us = dpp_zf<0x112>(uu); uu = uu + a * us; a = a * as; }
                { const float as = dpp_keep<0x114>(1.0f, a), us = dpp_zf<0x114>(uu); uu = uu + a * us; a = a * as; }
                { const float as = dpp_keep<0x118>(1.0f, a), us = dpp_zf<0x118>(uu); uu = uu + a * us; a = a * as; }
                hl[r] = uu + a * cH[ob][r]; ac[r] = a * cA[ob][r];
                cH[ob][r] = __shfl(hl[r], (lane & 48) | 15); cA[ob][r] = __shfl(ac[r], (lane & 48) | 15);
            }
            hp[2 * ob] = cvt_pk_bf16(hl[0], hl[1]); hp[2 * ob + 1] = cvt_pk_bf16(hl[2], hl[3]);
            ap[2 * ob] = cvt_pk_bf16(ac[0], ac[1]); ap[2 * ob + 1] = cvt_pk_bf16(ac[2], ac[3]);
        }
        { LAS bf16_t* hr = HLs + (16 * tb + fr) * HSTR + chb; LAS bf16_t* ar = ACs + (16 * tb + fr) * HSTR + chb;
          *(LAS u32x4*)hr = (u32x4){hp[0], hp[1], hp[2], hp[3]}; *(LAS u32x4*)(hr + 8) = (u32x4){hp[4], hp[5], hp[6], hp[7]};
          *(LAS u32x4*)ar = (u32x4){ap[0], ap[1], ap[2], ap[3]}; *(LAS u32x4*)(ar + 8) = (u32x4){ap[4], ap[5], ap[6], ap[7]}; }
    }
    if (fr == 0) {
        unsigned* sa = (unsigned*)(SUMM + ((size_t)(b * 32 + c) * 2 + 0) * 512 + chb); unsigned* sh = sa + 512;
#pragma unroll
        for (int ob = 0; ob < 4; ++ob)
#pragma unroll
            for (int r = 0; r < 4; ++r) {
                __hip_atomic_store(sa + 4 * ob + r, __float_as_uint(cA[ob][r]), __ATOMIC_RELAXED, __HIP_MEMORY_SCOPE_AGENT);
                __hip_atomic_store(sh + 4 * ob + r, __float_as_uint(cH[ob][r]), __ATOMIC_RELAXED, __HIP_MEMORY_SCOPE_AGENT);
            }
    }
    asm volatile("s_waitcnt vmcnt(0) lgkmcnt(0)" ::: "memory");
    __syncthreads();
    if (tid == 0) __hip_atomic_store(FLAG + 16 * u, 1u, __ATOMIC_RELAXED, __HIP_MEMORY_SCOPE_AGENT);
    if (tid < c) {
        unsigned sp = 0;
        while (__hip_atomic_load(FLAG + 16 * (b * 32 + tid), __ATOMIC_RELAXED, __HIP_MEMORY_SCOPE_AGENT) == 0u) { __builtin_amdgcn_s_sleep(2); if (++sp > (1u << 22)) break; }
    }
    __syncthreads();
    {
        float H = 0.f;
        for (int c0 = 0; c0 < c; c0 += 16) {
            float sa[16], sh[16];
#pragma unroll
            for (int q = 0; q < 16; ++q) { const int cp = (c0 + q < c) ? (c0 + q) : 0; const unsigned* sp_ = (const unsigned*)SUMM + ((size_t)(b * 32 + cp) * 2) * 512 + tid;
                sa[q] = __uint_as_float(__hip_atomic_load(sp_, __ATOMIC_RELAXED, __HIP_MEMORY_SCOPE_AGENT)); sh[q] = __uint_as_float(__hip_atomic_load(sp_ + 512, __ATOMIC_RELAXED, __HIP_MEMORY_SCOPE_AGENT)); }
#pragma unroll
            for (int q = 0; q < 16; ++q) if (c0 + q < c) H = sa[q] * H + sh[q];
        }
        Hs[tid] = H;
    }
    __syncthreads();
    {
        const f32x4 H0 = *(const LAS f32x4*)(Hs + 8 * lane), H1 = *(const LAS f32x4*)(Hs + 8 * lane + 4);
        const f32x4 g0 = *(const f32x4*)(g_lru + 8 * lane), g1 = *(const f32x4*)(g_lru + 8 * lane + 4);
#pragma unroll
        for (int j = 0; j < 8; ++j) {
            const int tk = 8 * wid + j; const size_t row = (size_t)b * SEQ + 64 * c + tk;
            const u32x4 hlw = *(const LAS u32x4*)(HLs + tk * HSTR + 8 * lane), acw = *(const LAS u32x4*)(ACs + tk * HSTR + 8 * lane), lgw = *(const u32x4*)(PROJ + row * INW + LGOFF + 8 * lane);
            const f32x4 hl0 = (f32x4){bf_lo(hlw.x), bf_hi(hlw.x), bf_lo(hlw.y), bf_hi(hlw.y)}, hl1 = (f32x4){bf_lo(hlw.z), bf_hi(hlw.z), bf_lo(hlw.w), bf_hi(hlw.w)};
            const f32x4 ac0 = (f32x4){bf_lo(acw.x), bf_hi(acw.x), bf_lo(acw.y), bf_hi(acw.y)}, ac1 = (f32x4){bf_lo(acw.z), bf_hi(acw.z), bf_lo(acw.w), bf_hi(acw.w)};
            const f32x4 lg0 = (f32x4){bf_lo(lgw.x), bf_hi(lgw.x), bf_lo(lgw.y), bf_hi(lgw.y)}, lg1 = (f32x4){bf_lo(lgw.z), bf_hi(lgw.z), bf_lo(lgw.w), bf_hi(lgw.w)};
            const f32x4 v0 = (hl0 + ac0 * H0) * gelu_tanh4(lg0), v1 = (hl1 + ac1 * H1) * gelu_tanh4(lg1);
            const f32x4 q = v0 * v0 + v1 * v1;
            const float rs = __builtin_amdgcn_rsqf(wave_sum((q.x + q.y) + (q.z + q.w)) * (1.f / 512.f) + RMS_EPS);
            const f32x4 o0 = v0 * rs * g0, o1 = v1 * rs * g1;
            u32x4 w;
            w.x = cvt_pk_bf16(o0.x, o0.y); w.y = cvt_pk_bf16(o0.z, o0.w); w.z = cvt_pk_bf16(o1.x, o1.y); w.w = cvt_pk_bf16(o1.z, o1.w);
            *(u32x4*)(MERGED + row * DM + 512 + 8 * lane) = w;
        }
    }
    __syncthreads();
}

__device__ __forceinline__ void lru_final_unit(LAS unsigned char* lds, const bf16_t* PROJ, const bf16_t* HL, const bf16_t* ACUM, const float* SUMM, const float* g_lru, bf16_t* MERGED,
                                               int u, int tid, int wid, int lane) {
    const int b = u >> 5, c = u & 31;
    LAS float* Hs = (LAS float*)lds;
    {
        float H = 0.f;
        for (int c0 = 0; c0 < c; c0 += 16) {
            float sa[16], sh[16];
#pragma unroll
            for (int q = 0; q < 16; ++q) { const int cp = (c0 + q < c) ? (c0 + q) : 0; const float* s = SUMM + ((size_t)(b * 32 + cp) * 2) * 512 + tid; sa[q] = s[0]; sh[q] = s[512]; }
#pragma unroll
            for (int q = 0; q < 16; ++q) if (c0 + q < c) H = sa[q] * H + sh[q];
        }
        Hs[tid] = H;
    }
    __syncthreads();
    const f32x4 H0 = *(const LAS f32x4*)(Hs + 8 * lane), H1 = *(const LAS f32x4*)(Hs + 8 * lane + 4);
    const f32x4 g0 = *(const f32x4*)(g_lru + 8 * lane), g1 = *(const f32x4*)(g_lru + 8 * lane + 4);
#pragma unroll
    for (int j = 0; j < 8; ++j) {
        const size_t row = (size_t)b * SEQ + 64 * c + 8 * wid + j;
        const u32x4 hlw = *(const u32x4*)(HL + row * 512 + 8 * lane), acw = *(const u32x4*)(ACUM + row * 512 + 8 * lane), lgw = *(const u32x4*)(PROJ + row * INW + LGOFF + 8 * lane);
        float v[8]; float ssq = 0.f;
#pragma unroll
        for (int e = 0; e < 8; ++e) {
            const unsigned hw = hlw[e >> 1], aw = acw[e >> 1], gw = lgw[e >> 1];
            const float hl = (e & 1) ? bf_hi(hw) : bf_lo(hw), ac = (e & 1) ? bf_hi(aw) : bf_lo(aw), lg = (e & 1) ? bf_hi(gw) : bf_lo(gw);
            const float Hc = e < 4 ? H0[e & 3] : H1[e & 3];
            const float hv = hl + ac * Hc;
            v[e] = hv * gelu_tanh(lg); ssq += v[e] * v[e];
        }
        const float rs = 1.0f / sqrtf(wave_sum(ssq) * (1.f / 512.f) + RMS_EPS);
        u32x4 w;
        w.x = cvt_pk_bf16(v[0] * rs * g0.x, v[1] * rs * g0.y); w.y = cvt_pk_bf16(v[2] * rs * g0.z, v[3] * rs * g0.w);
        w.z = cvt_pk_bf16(v[4] * rs * g1.x, v[5] * rs * g1.y); w.w = cvt_pk_bf16(v[6] * rs * g1.z, v[7] * rs * g1.w);
        *(u32x4*)(MERGED + row * DM + 512 + 8 * lane) = w;
    }
    __syncthreads();
}

#define XB_TMO      128
#define XB_XCNT(j)  (256  + 64 * (j))
#define XB_XSUB(j)  (1280 + 64 * (j))
#define XB_XGEN(j)  (2304 + 64 * (j))
#define XB_TOP      3328
#define XB_TOPGEN   3392
#define XCD_BAR_WORDS 3456
#define XB_SPIN_CAP (1u << 18)
__device__ __forceinline__ unsigned xb_ld(unsigned* p)              { return __hip_atomic_load(p, __ATOMIC_RELAXED, __HIP_MEMORY_SCOPE_AGENT); }
__device__ __forceinline__ unsigned xb_add(unsigned* p, unsigned v) { return __hip_atomic_fetch_add(p, v, __ATOMIC_RELAXED, __HIP_MEMORY_SCOPE_AGENT); }
__device__ __forceinline__ unsigned xb_xcc_id() { return (unsigned)__builtin_amdgcn_s_getreg((3 << 11) | 20) & 0xFu; }
#define XB_SPIN(cond, bar) do { unsigned _sp = 0; while (cond) { __builtin_amdgcn_s_sleep(1); \
    if ((++_sp & 255u) == 0u) { if (xb_ld(&(bar)[XB_TMO])) break; if (_sp > XB_SPIN_CAP) { atomicAdd(&(bar)[XB_TMO], 1u); break; } } } } while (0)
#define SEAM(k) SEAM2(k, (k) + 1)
struct XcdBarrier { unsigned* bar; unsigned x; volatile LAS unsigned* st; };
__device__ __forceinline__ XcdBarrier xcd_barrier_post(unsigned* bar, volatile LAS unsigned* st) {
    XcdBarrier b; b.bar = bar; b.x = xb_xcc_id(); b.st = st;
    if (threadIdx.x == 0) st[2] = xb_add(&bar[XB_XCNT(b.x)], 1u);
    return b;
}
__device__ __forceinline__ void xcd_barrier_complete(unsigned* bar, unsigned x, unsigned& nloc, unsigned& nx) {
    const unsigned G = gridDim.x * gridDim.y * gridDim.z;
    unsigned sum, cnt, mine, sp = 0u;
    for (;;) {
        sum = 0u; cnt = 0u; mine = 0u;
#pragma unroll
        for (unsigned j = 0; j < 16; ++j) { const unsigned c = xb_ld(&bar[XB_XCNT(j)]); sum += c; cnt += (c > 0u) ? 1u : 0u; mine = (j == x) ? c : mine; }
        if (sum == G) break;
        __builtin_amdgcn_s_sleep(1);
        if ((++sp & 255u) == 0u) { if (xb_ld(&bar[XB_TMO])) break; if (sp > XB_SPIN_CAP) { atomicAdd(&bar[XB_TMO], 1u); break; } }
    }
    nloc = mine > 0u ? mine : 1u; nx = cnt > 0u ? cnt : 1u;
}
__device__ __forceinline__ void xcd_barrier(const XcdBarrier& b) {
    asm volatile("s_waitcnt vmcnt(0)" ::: "memory");
    __syncthreads();
    if (threadIdx.x == 0) {
        unsigned* bar = b.bar;
        __builtin_amdgcn_s_waitcnt(0);
        unsigned nloc = b.st[0], nx = b.st[1];
        if (nloc == 0u) { xcd_barrier_complete(bar, b.x, nloc, nx); b.st[0] = nloc; b.st[1] = nx; }
        const unsigned old = xb_add(&bar[XB_XSUB(b.x)], 1u);
        const unsigned gen = old / nloc;
        if (old + 1u == (gen + 1u) * nloc) {
            __builtin_amdgcn_fence(__ATOMIC_RELEASE, "agent");
            asm volatile("s_waitcnt vmcnt(0)" ::: "memory");
            const unsigned og = xb_add(&bar[XB_TOP], 1u);
            const unsigned tg = og / nx;
            if (og + 1u == (tg + 1u) * nx) xb_add(&bar[XB_TOPGEN], 1u);
            else XB_SPIN(xb_ld(&bar[XB_TOPGEN]) == tg, bar);
            __builtin_amdgcn_fence(__ATOMIC_ACQUIRE, "agent");
            xb_add(&bar[XB_XGEN(b.x)], 1u);
            asm volatile("s_waitcnt vmcnt(0)" ::: "memory");
        } else {
            XB_SPIN(xb_ld(&bar[XB_XGEN(b.x)]) == gen, bar);
            __builtin_amdgcn_fence(__ATOMIC_ACQUIRE, "agent");
            asm volatile("s_waitcnt vmcnt(0)" ::: "memory");
        }
    }
    __syncthreads();
}

#define XL_SUB(j) (3456 + 32 * (j))
#define XL_GEN(j) (3456 + 256 + 32 * (j))
__device__ __forceinline__ void xcc_local_barrier(const XcdBarrier& b) {
    asm volatile("s_waitcnt vmcnt(0)" ::: "memory");
    __syncthreads();
    if (threadIdx.x == 0) {
        unsigned* bar = b.bar;
        __builtin_amdgcn_s_waitcnt(0);
        const unsigned nloc = b.st[0];
        const unsigned old = xb_add(&bar[XL_SUB(b.x)], 1u);
        const unsigned gen = old / nloc;
        if (old + 1u == (gen + 1u) * nloc) xb_add(&bar[XL_GEN(b.x)], 1u);
        else XB_SPIN(xb_ld(&bar[XL_GEN(b.x)]) == gen, bar);
        __builtin_amdgcn_fence(__ATOMIC_ACQUIRE, "agent");
        asm volatile("s_waitcnt vmcnt(0)" ::: "memory");
    }
    __syncthreads();
}

struct Args { const float* in[21]; float* out; unsigned char* ws; int ph_lo, ph_hi; };
constexpr int N_PHASES = 10;

__global__ void __launch_bounds__(512, 2) mk_fwd(Args a) {
    extern __shared__ __attribute__((aligned(16))) unsigned char lds_raw[];
    LAS unsigned char* lds = (LAS unsigned char*)lds_raw;
    const int tid = threadIdx.x, lane = tid & 63, wid = __builtin_amdgcn_readfirstlane(tid >> 6);
    const int G = gridDim.x, bid = blockIdx.x;
    const int gw = bid * 8 + wid, NGW = G * 8;
    unsigned char* ws = a.ws;
    const float* x = a.in[0];
    bf16_t* WinT = (bf16_t*)(ws + WS_WIN); bf16_t* WoutT = (bf16_t*)(ws + WS_WOUT); bf16_t* WupT = (bf16_t*)(ws + WS_WUP); bf16_t* WdnT = (bf16_t*)(ws + WS_WDN);
    bf16_t* WaT = (bf16_t*)(ws + WS_WAT); bf16_t* WxT = WaT + 8 * 64 * 64; float* SP = (float*)(ws + WS_WAT + 131072);
    float* SUMM = (float*)(ws + WS_SUMM);
    bf16_t* HN = (bf16_t*)(ws + WS_HN); bf16_t* PROJ = (bf16_t*)(ws + WS_R1); float* Y = (float*)(ws + WS_R1);
    bf16_t* MERGED = (bf16_t*)(ws + WS_MERGED); bf16_t* HL = (bf16_t*)(ws + WS_HL); bf16_t* ACUM = (bf16_t*)(ws + WS_ACUM);
    bf16_t* GB = (bf16_t*)(ws + WS_G); bf16_t* EDGE = (bf16_t*)(ws + WS_EDGE);
    float* RS1 = (float*)(ws + WS_XB + 3 * M * 4 * 4); float* RS2 = RS1 + M;
    float* out = a.out; bf16_t* X1B = (bf16_t*)(ws + WS_MERGED);
    unsigned* XB0 = (unsigned*)(ws + WS_XB); unsigned* XB1 = XB0 + M * 4; unsigned* XB2 = XB1 + M * 4;
    unsigned* WUPCNT = (unsigned*)ws + 4032;
    unsigned* CNT0 = (unsigned*)(ws + 16384); unsigned* CNT1 = CNT0 + 64 * 64; unsigned* CNT2 = CNT1 + 64 * 64; unsigned* CNT3 = CNT2 + 64 * 64; unsigned* FLAGS = CNT3 + 64 * 64;
    const int lo = a.ph_lo, hi = a.ph_hi;
    volatile LAS unsigned* MISC = (volatile LAS unsigned*)(lds + LDS_BYTES - 256);
    if (tid < 32) MISC[tid] = 0u;
    __syncthreads();
    XcdBarrier bar; bar.bar = (unsigned*)ws; bar.x = 0; bar.st = MISC + 8;
    if (hi - lo > 1) bar = xcd_barrier_post((unsigned*)ws, MISC + 8);
#ifndef PH_MASK
#define PH_MASK 0x3ff
#endif
#define IN(k) (((PH_MASK >> (k)) & 1) && lo <= (k) && (k) < hi)
#ifndef PROBE_DUP
#define PROBE_DUP 0x0
#endif
#define REP(k) for (int rep_ = 0; rep_ < ((((PROBE_DUP) >> (k)) & 1) ? 3 : 1); ++rep_)
#ifndef PROBE_SYNC
#define PROBE_SYNC 0
#endif
#define SEAM2(k, k2) do { if (IN(k) && IN(k2)) { xcd_barrier(bar); if (PROBE_SYNC && (k) == 0) for (int q_ = 0; q_ < 10; ++q_) xcd_barrier(bar); } } while (0)

    if (IN(0)) REP(0) {
        LAS float* scr = (LAS float*)(lds + wid * 16640);
        constexpr int I_IN = (DM / 64) * (INW / 64), I_OUT = (DM / 64) * (DM / 64), I_DN = (DFF / 64) * (DM / 64);
        for (int m = gw; m < M; m += NGW) row_to_bf16_rs(x + (size_t)m * DM, HN + (size_t)m * DM, RS1 + m, lane);
        for (int it = gw; it < I_IN + I_OUT + I_DN; it += NGW) {
            int r = it;
            if (r < I_IN) { p0_transpose_item<false>(a.in[2], DM, INW, WinT, scr, r, lane, a.in[1]); continue; } r -= I_IN;
            if (r < I_OUT) { p0_transpose_item<false>(a.in[13], DM, DM, WoutT, scr, r, lane); continue; } r -= I_OUT;
            p0_transpose_item<false>(a.in[19], DFF, DM, WdnT, scr, r, lane);
        }
        for (int i = bid * 512 + tid; i < 2 * 8 * 64 * 64; i += G * 512) {
            const int mat = i >> 15, r = i & 32767, hh = r >> 12, o = (r >> 6) & 63, ii = r & 63;
            const float v = (mat ? a.in[8] : a.in[6])[(hh * 64 + ii) * 64 + o];
            (mat ? WxT : WaT)[r] = (bf16_t)(cvt_pk_bf16(v, 0.f) & 0xffffu);
        }
        for (int i = bid * 512 + tid; i < 512; i += G * 512) SP[i] = log1pf(expf(-a.in[10][i]));
        __syncthreads();
    }
    SEAM(0);
    int vb = bid; bool xlocal = false;
    if (hi - lo > 1) {
        if (tid == 0) {
            bool ok = (G == 256);
            for (unsigned j = 0; j < 16; ++j) { const unsigned cn = xb_ld(&bar.bar[XB_XCNT(j)]); ok = ok && (cn == (j < 8 ? (unsigned)(G / 8) : 0u)); }
            MISC[3 + 8] = ok ? 1u : 0u;
        }
        __syncthreads();
        xlocal = MISC[3 + 8] != 0u;
        if (xlocal) vb = (int)MISC[2 + 8] * 8 + (int)bar.x;
    }
    vb = __builtin_amdgcn_readfirstlane(vb);
#define SEAML(k, k2) do { if (IN(k) && IN(k2)) { if (xlocal) xcc_local_barrier(bar); else xcd_barrier(bar); } } while (0)
    if (IN(1)) REP(1) {
        pg8::Gemm g{HN, WinT, M, INW, DM}; pg8::StaticOrder S; S.init(M, INW, G, vb);
        pg8::EpiBf16 E{PROJ, INW, RS1};
        pg8::gemm_phase<pg8::EpiBf16, pg8::StaticOrder, true, true>(lds, g, S, E);
        {
            constexpr int NU = (M / 256) * (INW / 256);
            const bool split = (G < NU) && (2 * G > NU);
            const int f0 = split ? (NU - G) : 0, nf = G - f0;
            if (vb >= f0) {
                LAS float* scr = (LAS float*)(lds + wid * 16640);
                constexpr int I_UP = (DM / 64) * (NUP / 64);
                for (int it = (vb - f0) * 8 + wid; it < I_UP; it += nf * 8) p0_transpose_item<true, true>(a.in[16], DM, NUP, WupT, scr, it, lane, a.in[15]);
                asm volatile("s_waitcnt vmcnt(0)" ::: "memory");
                __syncthreads();
                if (tid == 0) __hip_atomic_fetch_add(WUPCNT, 1u, __ATOMIC_RELAXED, __HIP_MEMORY_SCOPE_AGENT);
            }
        }
    }
    SEAML(1, 2);
    if (IN(2)) REP(2) {
#ifndef NO_ATTN
        { const int u = (vb & 7) * 32 + (vb >> 3); attn_unit(lds, PROJ, MERGED, a.in[3], a.in[11], u, tid, wid, lane); }
#endif
#ifndef NO_LRU
        { const int u = (vb & 7) * 32 + (vb >> 3); lru_unit(lds, PROJ, WaT, WxT, a.in[4], a.in[5], a.in[7], a.in[9], SP, SUMM, FLAGS, a.in[12], MERGED, u, tid, wid, lane); }
#endif
    }
    SEAML(2, 4);
    if (IN(4)) REP(4) {
        pg8::Gemm g{MERGED, WoutT, M, DM, DM}; pg8::StaticOrder S; S.init(M, DM, G, vb);
        pg8::PanelRms st1{XB0, CNT0}, st2{XB1, CNT1};
        pg8::EpiRmsResRms E{HN, X1B, (float*)XB1, a.in[14], st1, st2};
        pg8::gemm_phase<pg8::EpiRmsResRms, pg8::StaticOrder, false, true>(lds, g, S, E);
    }
    SEAML(4, 6);
    if (IN(6)) REP(6) {
        {
            constexpr int NU1 = (M / 256) * (INW / 256);
            const unsigned want = (unsigned)(((G < NU1) && (2 * G > NU1)) ? (2 * G - NU1) : G);
            if (tid == 0) { unsigned sp = 0; while (__hip_atomic_load(WUPCNT, __ATOMIC_RELAXED, __HIP_MEMORY_SCOPE_AGENT) < want) { __builtin_amdgcn_s_sleep(2); if (++sp > (1u << 22)) break; } }
            __syncthreads();
        }
        pg8::Gemm g{X1B, WupT, M, NUP, DM}; pg8::HalfTailOrder S; S.init(M, NUP, G, vb);
        pg8::EpiConvGate E{GB, EDGE, a.in[17], a.in[18], (const float*)XB1};
        pg8::gemm_phase<pg8::EpiConvGate, pg8::HalfTailOrder, true, true>(lds, g, S, E);
    }
    SEAML(6, 8);
    if (IN(8)) REP(8) {
        pg8::Gemm g{GB, WdnT, M, DM, DFF}; pg8::StaticOrder S; S.init(M, DM, G, vb);
        {
            const float* cw = a.in[17]; const float* cb = a.in[18];
            pg8::Unit uu;
            if (S.next(0, uu)) {
                const int B = 4 * uu.pm + uu.pn;
                const bool zero = (B % 32) == 0; const int Bp = zero ? B : B - 1;
#pragma unroll 3
                for (int idx = tid; idx < 2 * (DFF / 4); idx += 512) {
                    const int rsel = idx >= (DFF / 4) ? 1 : 0, ch = 4 * (idx - rsel * (DFF / 4));
                    f32x4 cv[2];
#pragma unroll
                    for (int gv = 0; gv < 2; ++gv) {
                        const int col = gv * DFF + ch;
                        const u32x2 r2 = *(const u32x2*)(EDGE + ((size_t)(Bp * 4 + 2) * 2 + gv) * DFF + ch), r1 = *(const u32x2*)(EDGE + ((size_t)(Bp * 4 + 3) * 2 + gv) * DFF + ch);
                        const u32x2 q0 = *(const u32x2*)(EDGE + ((size_t)(B * 4 + 0) * 2 + gv) * DFF + ch), q1 = *(const u32x2*)(EDGE + ((size_t)(B * 4 + 1) * 2 + gv) * DFF + ch);
                        f32x4 fm2 = (f32x4){bf_lo(r2.x), bf_hi(r2.x), bf_lo(r2.y), bf_hi(r2.y)}, fm1 = (f32x4){bf_lo(r1.x), bf_hi(r1.x), bf_lo(r1.y), bf_hi(r1.y)};
                        if (zero) { fm2 = (f32x4){0.f, 0.f, 0.f, 0.f}; fm1 = fm2; }
                        const f32x4 f0 = (f32x4){bf_lo(q0.x), bf_hi(q0.x), bf_lo(q0.y), bf_hi(q0.y)}, f1 = (f32x4){bf_lo(q1.x), bf_hi(q1.x), bf_lo(q1.y), bf_hi(q1.y)};
                        const f32x4 w0 = *(const f32x4*)(cw + col), w1 = *(const f32x4*)(cw + NUP + col), w2 = *(const f32x4*)(cw + 2 * NUP + col), bb = *(const f32x4*)(cb + col);
                        cv[gv] = rsel == 0 ? (w0 * fm2 + w1 * fm1 + w2 * f0 + bb) : (w0 * fm1 + w1 * f0 + w2 * f1 + bb);
                    }
                    const f32x4 go = gelu_tanh4(cv[0]) * cv[1];
                    u32x2 w; w.x = cvt_pk_bf16(go.x, go.y); w.y = cvt_pk_bf16(go.z, go.w);
                    *(u32x2*)(GB + (size_t)(64 * B + rsel) * DFF + ch) = w;
                }
                asm volatile("s_waitcnt vmcnt(0)" ::: "memory");
                __syncthreads();
                if (tid == 0) {
                    if (!xlocal) { __builtin_amdgcn_fence(__ATOMIC_RELEASE, "agent"); asm volatile("s_waitcnt vmcnt(0)" ::: "memory"); }
                    __hip_atomic_fetch_add(CNT3 + 64 * uu.pm, 1u, __ATOMIC_RELAXED, __HIP_MEMORY_SCOPE_AGENT);
                    unsigned sp = 0;
                    while (__hip_atomic_load(CNT3 + 64 * uu.pm, __ATOMIC_RELAXED, __HIP_MEMORY_SCOPE_AGENT) < 4u) { __builtin_amdgcn_s_sleep(2); if (++sp > (1u << 22)) break; }
                    __builtin_amdgcn_fence(__ATOMIC_ACQUIRE, "agent");
                    asm volatile("s_waitcnt vmcnt(0)" ::: "memory");
                }
                __syncthreads();
            }
        }
        pg8::PanelRms st{XB2, CNT2};
        pg8::EpiRmsRes E{X1B, out, a.in[20], st};
        pg8::gemm_phase<pg8::EpiRmsRes, pg8::StaticOrder, false, true>(lds, g, S, E);
    }
#undef IN
#undef SEAM
}

extern "C" void kernel_launch(void* const* d_in, const int* in_sizes, int n_in, void* d_out, int out_size, void* d_ws, size_t ws_size, hipStream_t stream) {
    static int grid = 0;
    if (grid == 0) {
        if (n_in != 21 || out_size != M * DM || ws_size < WS_END) { fprintf(stderr, "kernel_launch: unexpected problem shape (n_in %d out %d ws %zu)\n", n_in, out_size, ws_size); grid = -1; return; }
        int dev = 0, cus = 0, per_cu = 0;
        hipGetDevice(&dev); hipDeviceGetAttribute(&cus, hipDeviceAttributeMultiprocessorCount, dev);
        if (hipFuncSetAttribute((const void*)mk_fwd, hipFuncAttributeMaxDynamicSharedMemorySize, LDS_BYTES) != hipSuccess) { fprintf(stderr, "kernel_launch: hipFuncSetAttribute failed\n"); grid = -1; return; }
        if (hipOccupancyMaxActiveBlocksPerMultiprocessor(&per_cu, (const void*)mk_fwd, 512, LDS_BYTES) != hipSuccess || per_cu < 1) { fprintf(stderr, "kernel_launch: occupancy query says %d\n", per_cu); per_cu = 1; }
        (void)hipGetLastError();
        grid = cus * 1;
        if (grid > 256) grid = 256;
    }
    if (grid < 0) return;
    Args a{};
    for (int i = 0; i < 21; ++i) a.in[i] = (const float*)d_in[i];
    a.out = (float*)d_out; a.ws = (unsigned char*)d_ws;
#if MK_N_LAUNCHES == 1
    if (hipMemsetAsync(d_ws, 0, 16384 + 4 * 64 * 64 * 4 + 256 * 16 * 4, stream) != hipSuccess) { fprintf(stderr, "kernel_launch: memset failed\n"); return; }
    a.ph_lo = 0; a.ph_hi = N_PHASES;
    void* args[] = {&a};
    hipError_t e = hipLaunchCooperativeKernel((const void*)mk_fwd, dim3(grid), dim3(512), args, LDS_BYTES, stream);
    if (e != hipSuccess) fprintf(stderr, "cooperative launch failed: %s (grid %d)\n", hipGetErrorString(e), grid);
#else
    for (int p = 0; p < N_PHASES; ++p) { a.ph_lo = p; a.ph_hi = p + 1; hipLaunchKernelGGL(mk_fwd, dim3(grid), dim3(512), LDS_BYTES, stream, a); }
#endif
}
```

```cpp
#include <hip/hip_runtime.h>
#include <hip/hip_cooperative_groups.h>
#include <cstdio>
#include <cstdint>
namespace cg = cooperative_groups;

#ifndef MK_N_LAUNCHES
#define MK_N_LAUNCHES 1
#endif

#define LAS __attribute__((address_space(3)))
typedef unsigned short bf16_t;
typedef short bf16x8 __attribute__((ext_vector_type(8)));
typedef float f32x4 __attribute__((ext_vector_type(4)));
typedef float f32x2 __attribute__((ext_vector_type(2)));
typedef unsigned u32x4 __attribute__((ext_vector_type(4)));
typedef unsigned u32x2 __attribute__((ext_vector_type(2)));

constexpr int BATCH = 8, SEQ = 2048, DM = 1024, M = BATCH * SEQ;
constexpr int INW = 1792, DFF = 2816, NUP = 2 * DFF;
constexpr int KOFF = 512, VOFF = 640, LXOFF = 768, LGOFF = 1280;
constexpr float RMS_EPS = 1e-6f;
constexpr float LOG2E = 1.4426950408889634f;

constexpr size_t MiB = 1u << 20;
constexpr size_t WS_WIN = 1 * MiB;
constexpr size_t WS_WOUT = 5 * MiB;
constexpr size_t WS_WUP = 7 * MiB;
constexpr size_t WS_WDN = 18 * MiB;
constexpr size_t WS_WAT = 23 * MiB + 512 * 1024;
constexpr size_t WS_SUMM = 24 * MiB;
constexpr size_t WS_HN = 26 * MiB;
constexpr size_t WS_R1 = 58 * MiB;
constexpr size_t WS_MERGED = 122 * MiB;
constexpr size_t WS_HL = 154 * MiB;
constexpr size_t WS_ACUM = 170 * MiB;
constexpr size_t WS_G = 154 * MiB;
constexpr size_t WS_EDGE = 242 * MiB;
constexpr size_t WS_XB = 25 * MiB;
constexpr size_t WS_END = 254 * MiB;

constexpr int LDS_BYTES = 163840;

__device__ __forceinline__ unsigned cvt_pk_bf16(float lo, float hi) { unsigned r; asm volatile("v_cvt_pk_bf16_f32 %0, %1, %2" : "=v"(r) : "v"(lo), "v"(hi)); return r; }
__device__ __forceinline__ float bf_lo(unsigned w) { return __uint_as_float(w << 16); }
__device__ __forceinline__ float bf_hi(unsigned w) { return __uint_as_float(w & 0xffff0000u); }
__device__ __forceinline__ float fast_exp2(float x) { return __builtin_amdgcn_exp2f(x); }
__device__ __forceinline__ float fast_rcp(float x) { return __builtin_amdgcn_rcpf(x); }
__device__ __forceinline__ float sigmoidf_(float z) { return fast_rcp(1.0f + fast_exp2(-LOG2E * z)); }
__device__ __forceinline__ float gelu_tanh(float x) {
    const float u = x * (1.0f + 0.044715f * x * x);
    return x * fast_rcp(1.0f + fast_exp2(-2.0f * 0.7978845608028654f * LOG2E * u));
}
__device__ __forceinline__ f32x4 gelu_tanh4(f32x4 x) {
    const f32x4 u = x * (x * x * 0.044715f + 1.0f);
    const f32x4 t = u * (-2.0f * 0.7978845608028654f * LOG2E);
    f32x4 e; e.x = fast_exp2(t.x); e.y = fast_exp2(t.y); e.z = fast_exp2(t.z); e.w = fast_exp2(t.w);
    const f32x4 d = e + 1.0f;
    f32x4 r; r.x = fast_rcp(d.x); r.y = fast_rcp(d.y); r.z = fast_rcp(d.z); r.w = fast_rcp(d.w);
    return x * r;
}
template <int CTRL> __device__ __forceinline__ float dpp_keep(float oldv, float v) {
    return __int_as_float(__builtin_amdgcn_update_dpp(__float_as_int(oldv), __float_as_int(v), CTRL, 0xf, 0xf, false));
}
template <int CTRL> __device__ __forceinline__ float dpp_zf(float v) {
    return __int_as_float(__builtin_amdgcn_update_dpp(0, __float_as_int(v), CTRL, 0xf, 0xf, true));
}
template <int CTRL> __device__ __forceinline__ float dpp_rot(float v) {
    return __int_as_float(__builtin_amdgcn_mov_dpp(__float_as_int(v), CTRL, 0xf, 0xf, true));
}
__device__ __forceinline__ float wave_sum(float v) {
#pragma unroll
    for (int o = 1; o < 64; o <<= 1) v += __shfl_xor(v, o);
    return v;
}

namespace pg8 {
constexpr int BM = 256, BK = 64, HALF = 128, HTB = HALF * BK * 2, STAGE_BYTES = 8 * HTB, NXCD = 8, WGM = 8;
__host__ __device__ __forceinline__ int lds_byte(int r, int c) { const int st = (r >> 4) * 2 + (c >> 5), rr = r & 15, cc = c & 31, ob = rr * 64 + cc * 2; return st * 1024 + (ob ^ (((ob >> 9) & 1) << 5)); }
__host__ __device__ __forceinline__ void stage_rc(int b, int& R, int& C) { const int st = b / 1024, sb = b % 1024, swz = sb ^ (((sb >> 9) & 1) << 5); R = (st >> 1) * 16 + swz / 64; C = (st & 1) * 32 + (swz % 64) / 2; }
__host__ __device__ __forceinline__ int perm32(int rho) { const int n = rho >> 4, i = rho & 15; return 8 * (i >> 2) + 4 * n + (i & 3); }
struct Unit { int pm, pn, half; };
struct Gemm { const bf16_t* A; const bf16_t* Bt; int M, N, K; };
struct StaticOrder {
    int nM, nN, nwg, G, c;
    __host__ __device__ void init(int M_, int N_, int G_, int c_) { nM = M_ / BM; nN = N_ / BM; nwg = nM * nN; G = G_; c = c_; }
    __host__ __device__ bool next(int i, Unit& u) const {
        const long L = (long)i * G + c; if (L >= nwg) return false;
        int wgid = (int)L; { const int q = nwg / NXCD, r = nwg % NXCD, xcd = wgid % NXCD, off = wgid / NXCD; wgid = (xcd < r ? xcd * (q + 1) : r * (q + 1) + (xcd - r) * q) + off; }
        const int nig = WGM * nN, gid = wgid / nig, fm = gid * WGM, gsz = (nM - fm) < WGM ? (nM - fm) : WGM;
        u.pm = fm + ((wgid % nig) % gsz); u.pn = (wgid % nig) / gsz; u.half = 0; return true;
    }
};
struct HalfTailOrder {
    StaticOrder so; int nfull, rem;
    __host__ __device__ void init(int M_, int N_, int G_, int c_) { so.init(M_, N_, G_, c_); nfull = so.nwg / G_; rem = so.nwg - nfull * G_; }
    __host__ __device__ bool next(int i, Unit& u) const {
        if (rem == 0 || 2 * rem > so.G || (rem % 8) != 0 || (so.G % 8) != 0) return so.next(i, u);
        if (i < nfull) return so.next(i, u);
        if (i > nfull || (so.c >> 3) >= 2 * (rem / 8)) return false;
        StaticOrder t = so; t.c = ((so.c >> 3) >> 1) * 8 + (so.c & 7);
        if (!t.next(nfull, u)) return false;
        u.half = 1 + ((so.c >> 3) & 1); return true;
    }
};
struct EpiBf16 {
    static constexpr bool CONV = false;
    static constexpr bool PERM = true;
    static constexpr bool AFTER_DRAIN = false;
    bf16_t* O; int ldc; const float* rowscale;
    __device__ __forceinline__ void operator()(const f32x4 (&acc)[2][2][4][2], const Unit& u, int wr, int wc, int fr, int fq) const {
        const int row0 = u.pm * BM + wr * 64 + fr, col0 = u.pn * BM + wc * 32 + 8 * fq;
        float rsv[2][4];
#pragma unroll
        for (int ai = 0; ai < 2; ++ai)
#pragma unroll
            for (int m = 0; m < 4; ++m) rsv[ai][m] = rowscale[row0 + ai * HALF + m * 16];
#pragma unroll
        for (int ai = 0; ai < 2; ++ai)
#pragma unroll
            for (int m = 0; m < 4; ++m) { const int row = row0 + ai * HALF + m * 16; const float rsc = rsv[ai][m]; bf16_t* rowp = O + (size_t)row * ldc + col0;
#pragma unroll
                for (int bj = 0; bj < 2; ++bj) { const f32x4 v0 = acc[ai][bj][m][0] * rsc, v1 = acc[ai][bj][m][1] * rsc;
                    u32x4 w; w.x = cvt_pk_bf16(v0[0], v0[1]); w.y = cvt_pk_bf16(v0[2], v0[3]); w.z = cvt_pk_bf16(v1[0], v1[1]); w.w = cvt_pk_bf16(v1[2], v1[3]); *(u32x4*)(rowp + bj * HALF) = w; } }
    }
};
struct EpiF32 {
    static constexpr bool CONV = false;
    static constexpr bool PERM = false;
    static constexpr bool AFTER_DRAIN = false;
    float* O; int ldc;
    __device__ __forceinline__ void operator()(const f32x4 (&acc)[2][2][4][2], const Unit& u, int wr, int wc, int fr, int fq) const {
        const int row0 = u.pm * BM + wr * 64 + fr, col0 = u.pn * BM + wc * 32 + 4 * fq;
#pragma unroll
        for (int ai = 0; ai < 2; ++ai)
#pragma unroll
            for (int m = 0; m < 4; ++m) { float* rowp = O + (size_t)(row0 + ai * HALF + m * 16) * ldc + col0;
#pragma unroll
                for (int bj = 0; bj < 2; ++bj)
#pragma unroll
                    for (int n = 0; n < 2; ++n) *(f32x4*)(rowp + bj * HALF + n * 16) = acc[ai][bj][m][n]; }
    }
};
struct EpiConvGate {
    static constexpr bool CONV = true;
    static constexpr bool PERM = true;
    static constexpr bool AFTER_DRAIN = false;
    bf16_t* G; bf16_t* E; const float* cw; const float* cb; const float* rowscale;
    static constexpr int CBUF_OFF = 131072, CBUF_BYTES = 8192;
    __device__ __forceinline__ void prefetch(LAS unsigned char* lds, const Unit& u, int buf, int tid, int wid) const {
        const int rowbase = u.pm * BM + (u.half == 2 ? HALF : 0);
#pragma unroll
        for (int it = 0; it < 4; ++it) {
            const int f = it * 512 + tid;
            const float* gp;
            if (f < 1024) { const int sgm = f >> 7, c = f & 127; const float* sb = (sgm & 3) == 3 ? cb : cw + (sgm & 3) * NUP; gp = sb + (sgm >> 2) * DFF + u.pn * 128 + c; }
            else gp = rowscale + (size_t)rowbase * 4 + (f - 1024);
            __builtin_amdgcn_global_load_lds((const unsigned*)gp, (LAS unsigned*)(lds + CBUF_OFF + buf * CBUF_BYTES + (it * 512 + wid * 64) * 4), 4, 0, 0);
        }
    }
    __device__ __forceinline__ void operator()(const f32x4 (&acc)[2][2][4][2], const Unit& u, int wr, int wc, int fr, int fq, LAS unsigned char* lds, int buf) const {
        const LAS float* CB = (const LAS float*)(lds + CBUF_OFF + buf * CBUF_BYTES);
        u32x2 pk0[2][4];
        float rsv[2][4];
#pragma unroll
        for (int ai = 0; ai < 2; ++ai)
#pragma unroll
            for (int m = 0; m < 4; ++m) { const f32x4 p = *(const LAS f32x4*)(CB + 1024 + 4 * ((u.half ? 0 : ai * HALF) + wr * 64 + 16 * m + fr));
                rsv[ai][m] = __builtin_amdgcn_rsqf(((p.x + p.y) + (p.z + p.w)) * (1.0f / 1024.0f) + RMS_EPS); }
#pragma unroll
        for (int n = 0; n < 2; ++n) {
            const int ch = u.pn * 128 + wc * 32 + 8 * fq + 4 * n;
            const int cc = wc * 32 + 8 * fq + 4 * n;
            const f32x4 wg0 = *(const LAS f32x4*)(CB + cc), wg1 = *(const LAS f32x4*)(CB + 128 + cc), wg2 = *(const LAS f32x4*)(CB + 256 + cc), bg = *(const LAS f32x4*)(CB + 384 + cc);
            const f32x4 wv0 = *(const LAS f32x4*)(CB + 512 + cc), wv1 = *(const LAS f32x4*)(CB + 640 + cc), wv2 = *(const LAS f32x4*)(CB + 768 + cc), bv = *(const LAS f32x4*)(CB + 896 + cc);
#pragma unroll
            for (int ai = 0; ai < 2; ++ai) {
                if (ai == 1 && u.half) continue;
                const int rb = u.pm * BM + (u.half == 2 ? HALF : 0) + ai * HALF + wr * 64, blk = rb >> 6;
                f32x4 pg = (f32x4){0.f, 0.f, 0.f, 0.f}, pv = pg;
#pragma unroll
                for (int m = 0; m < 4; ++m) {
                    const float rsc = rsv[ai][m];
                    const f32x4 g = acc[ai][0][m][n] * rsc, v = acc[ai][1][m][n] * rsc;
                    if (m == 0 && fr < 2) { bf16_t* e = E + ((size_t)(blk * 4 + fr) * 2) * DFF + ch; *(u32x2*)e = (u32x2){cvt_pk_bf16(g[0], g[1]), cvt_pk_bf16(g[2], g[3])}; *(u32x2*)(e + DFF) = (u32x2){cvt_pk_bf16(v[0], v[1]), cvt_pk_bf16(v[2], v[3])}; }
                    if (m == 3 && fr >= 14) { bf16_t* e = E + ((size_t)(blk * 4 + fr - 12) * 2) * DFF + ch; *(u32x2*)e = (u32x2){cvt_pk_bf16(g[0], g[1]), cvt_pk_bf16(g[2], g[3])}; *(u32x2*)(e + DFF) = (u32x2){cvt_pk_bf16(v[0], v[1]), cvt_pk_bf16(v[2], v[3])}; }
                    f32x4 sg1, sg2, sv1, sv2;
#pragma unroll
                    for (int j = 0; j < 4; ++j) { sg1[j] = fr == 15 ? pg[j] : g[j]; sg2[j] = fr >= 14 ? pg[j] : g[j]; sv1[j] = fr == 15 ? pv[j] : v[j]; sv2[j] = fr >= 14 ? pv[j] : v[j]; }
                    f32x4 g1, g2, v1, v2;
#pragma unroll
                    for (int j = 0; j < 4; ++j) { g1[j] = dpp_rot<0x121>(sg1[j]); g2[j] = dpp_rot<0x122>(sg2[j]); v1[j] = dpp_rot<0x121>(sv1[j]); v2[j] = dpp_rot<0x122>(sv2[j]); }
                    const f32x4 cgv = wg0 * g2 + wg1 * g1 + wg2 * g + bg;
                    const f32x4 cvv = wv0 * v2 + wv1 * v1 + wv2 * v + bv;
                    const f32x4 o = gelu_tanh4(cgv) * cvv;
                    u32x2 w; w.x = cvt_pk_bf16(o[0], o[1]); w.y = cvt_pk_bf16(o[2], o[3]);
                    if (n == 0) pk0[ai][m] = w;
                    else *(u32x4*)(G + (size_t)(rb + 16 * m + fr) * DFF + ch - 4) = (u32x4){pk0[ai][m].x, pk0[ai][m].y, w.x, w.y};
                    pg = g; pv = v;
                }
            }
        }
    }
};

struct PanelRms {
    unsigned* xbuf;
    unsigned* cnt;
    __device__ __forceinline__ void run(const f32x4 (&v)[2][2][4][2], const Unit& u, int wr, int wc, int fr, int fq, LAS unsigned char* lds, int wid, int lane) const {
        LAS float* P = (LAS float*)lds;
        LAS float* S = (LAS float*)(lds + 8192);
#pragma unroll
        for (int ai = 0; ai < 2; ++ai)
#pragma unroll
            for (int m = 0; m < 4; ++m) {
                float s = 0.f;
#pragma unroll
                for (int bj = 0; bj < 2; ++bj)
#pragma unroll
                    for (int n = 0; n < 2; ++n) { const f32x4 x = v[ai][bj][m][n]; s += (x[0] * x[0] + x[1] * x[1]) + (x[2] * x[2] + x[3] * x[3]); }
                s += __shfl_xor(s, 16); s += __shfl_xor(s, 32);
                if (fq == 0) P[(ai * HALF + wr * 64 + m * 16 + fr) * 4 + wc] = s;
            }
        asm volatile("s_waitcnt lgkmcnt(0)" ::: "memory"); __builtin_amdgcn_s_barrier(); asm volatile("" ::: "memory");
        const int row = wid * 32 + (lane & 31);
        if (lane < 32) {
            const f32x4 p = *(const LAS f32x4*)(P + row * 4);
            __hip_atomic_store(xbuf + (size_t)(u.pm * BM + row) * 4 + u.pn, __float_as_uint((p.x + p.y) + (p.z + p.w)), __ATOMIC_RELAXED, __HIP_MEMORY_SCOPE_AGENT);
        }
        asm volatile("s_waitcnt vmcnt(0)" ::: "memory");
        if (lane == 0) __hip_atomic_fetch_add(cnt + 64 * u.pm, 1u, __ATOMIC_RELAXED, __HIP_MEMORY_SCOPE_AGENT);
        if (wid == 0) {
            unsigned sp = 0;
            while ((unsigned)__builtin_amdgcn_readfirstlane(__hip_atomic_load(cnt + 64 * u.pm, __ATOMIC_RELAXED, __HIP_MEMORY_SCOPE_AGENT)) < 32u) { __builtin_amdgcn_s_sleep(2); if (++sp > (1u << 22)) break; }
        }
        asm volatile("s_waitcnt vmcnt(0) lgkmcnt(0)" ::: "memory"); __builtin_amdgcn_s_barrier(); asm volatile("" ::: "memory");
        if (lane < 32) {
            const unsigned* slot = xbuf + (size_t)(u.pm * BM + row) * 4; float tot = 0.f;
#pragma unroll
            for (int t = 0; t < 4; ++t) tot += __uint_as_float(__hip_atomic_load(slot + t, __ATOMIC_RELAXED, __HIP_MEMORY_SCOPE_AGENT));
            S[row] = 1.0f / sqrtf(tot * (1.0f / 1024.0f) + RMS_EPS);
        }
        asm volatile("s_waitcnt lgkmcnt(0)" ::: "memory"); __builtin_amdgcn_s_barrier(); asm volatile("" ::: "memory");
    }
};
__device__ __forceinline__ void publish_row_ssq(const f32x4 (&v)[2][2][4][2], const Unit& u, int wr, int wc, int fr, int fq, LAS unsigned char* lds, int wid, int lane, float* pbuf) {
    LAS float* P = (LAS float*)lds;
#pragma unroll
    for (int ai = 0; ai < 2; ++ai)
#pragma unroll
        for (int m = 0; m < 4; ++m) {
            float s = 0.f;
#pragma unroll
            for (int bj = 0; bj < 2; ++bj)
#pragma unroll
                for (int n = 0; n < 2; ++n) { const f32x4 x = v[ai][bj][m][n]; s += (x[0] * x[0] + x[1] * x[1]) + (x[2] * x[2] + x[3] * x[3]); }
            s += __shfl_xor(s, 16); s += __shfl_xor(s, 32);
            if (fq == 0) P[(ai * HALF + wr * 64 + m * 16 + fr) * 4 + wc] = s;
        }
    asm volatile("s_waitcnt lgkmcnt(0)" ::: "memory"); __builtin_amdgcn_s_barrier(); asm volatile("" ::: "memory");
    const int row = wid * 32 + (lane & 31);
    if (lane < 32) { const f32x4 p = *(const LAS f32x4*)(P + row * 4); pbuf[(size_t)(u.pm * BM + row) * 4 + u.pn] = (p.x + p.y) + (p.z + p.w); }
}
struct EpiRmsResRms {
    static constexpr bool CONV = false;
    static constexpr bool PERM = true;
    static constexpr bool AFTER_DRAIN = true;
    const bf16_t* xb; bf16_t* x1b; float* rs2; const float* g1; PanelRms st1, st2;
    __device__ __forceinline__ void fused(f32x4 (&acc)[2][2][4][2], const Unit& u, int wr, int wc, int fr, int fq, LAS unsigned char* lds, int wid, int lane) const {
        const LAS float* S = (const LAS float*)(lds + 8192);
        const int col0 = u.pn * BM + wc * 32 + 8 * fq;
        u32x4 pre[2][4][2];
#pragma unroll
        for (int ai = 0; ai < 2; ++ai)
#pragma unroll
            for (int m = 0; m < 4; ++m) { const size_t off = (size_t)(u.pm * BM + ai * HALF + wr * 64 + m * 16 + fr) * DM + col0;
#pragma unroll
                for (int bj = 0; bj < 2; ++bj) pre[ai][m][bj] = *(const u32x4*)(xb + off + bj * HALF); }
        st1.run(acc, u, wr, wc, fr, fq, lds, wid, lane);
        f32x4 gv[2][2];
#pragma unroll
        for (int bj = 0; bj < 2; ++bj)
#pragma unroll
            for (int n = 0; n < 2; ++n) gv[bj][n] = *(const f32x4*)(g1 + col0 + bj * HALF + 4 * n);
#pragma unroll
        for (int ai = 0; ai < 2; ++ai)
#pragma unroll
            for (int m = 0; m < 4; ++m) { const int r = ai * HALF + wr * 64 + m * 16 + fr; const float rs = S[r]; const size_t off = (size_t)(u.pm * BM + r) * DM + col0;
#pragma unroll
                for (int bj = 0; bj < 2; ++bj) { const u32x4 p = pre[ai][m][bj];
                    const f32x4 x0 = (f32x4){bf_lo(p.x), bf_hi(p.x), bf_lo(p.y), bf_hi(p.y)} + acc[ai][bj][m][0] * rs * gv[bj][0];
                    const f32x4 x1 = (f32x4){bf_lo(p.z), bf_hi(p.z), bf_lo(p.w), bf_hi(p.w)} + acc[ai][bj][m][1] * rs * gv[bj][1];
                    acc[ai][bj][m][0] = x0; acc[ai][bj][m][1] = x1;
                    u32x4 w; w.x = cvt_pk_bf16(x0[0], x0[1]); w.y = cvt_pk_bf16(x0[2], x0[3]); w.z = cvt_pk_bf16(x1[0], x1[1]); w.w = cvt_pk_bf16(x1[2], x1[3]);
                    *(u32x4*)(x1b + off + bj * HALF) = w; }
                if (m & 1) asm volatile("" ::: "memory"); }
        publish_row_ssq(acc, u, wr, wc, fr, fq, lds, wid, lane, rs2);
    }
};
struct EpiRmsRes {
    static constexpr bool CONV = false;
    static constexpr bool PERM = true;
    static constexpr bool AFTER_DRAIN = true;
    const bf16_t* x1b; float* out; const float* g; PanelRms st;
    __device__ __forceinline__ void fused(f32x4 (&acc)[2][2][4][2], const Unit& u, int wr, int wc, int fr, int fq, LAS unsigned char* lds, int wid, int lane) const {
        const LAS float* S = (const LAS float*)(lds + 8192);
        const int col0 = u.pn * BM + wc * 32 + 8 * fq;
        u32x4 pre[2][4][2];
#pragma unroll
        for (int ai = 0; ai < 2; ++ai)
#pragma unroll
            for (int m = 0; m < 4; ++m) { const size_t off = (size_t)(u.pm * BM + ai * HALF + wr * 64 + m * 16 + fr) * DM + col0;
#pragma unroll
                for (int bj = 0; bj < 2; ++bj) pre[ai][m][bj] = *(const u32x4*)(x1b + off + bj * HALF); }
        st.run(acc, u, wr, wc, fr, fq, lds, wid, lane);
        f32x4 gv[2][2];
#pragma unroll
        for (int bj = 0; bj < 2; ++bj)
#pragma unroll
            for (int n = 0; n < 2; ++n) gv[bj][n] = *(const f32x4*)(g + col0 + bj * HALF + 4 * n);
#pragma unroll
        for (int ai = 0; ai < 2; ++ai)
#pragma unroll
            for (int m = 0; m < 4; ++m) { const int r = ai * HALF + wr * 64 + m * 16 + fr; const float rs = S[r]; const size_t off = (size_t)(u.pm * BM + r) * DM + col0;
#pragma unroll
                for (int bj = 0; bj < 2; ++bj) { const u32x4 p = pre[ai][m][bj];
                    *(f32x4*)(out + off + bj * HALF) = (f32x4){bf_lo(p.x), bf_hi(p.x), bf_lo(p.y), bf_hi(p.y)} + acc[ai][bj][m][0] * rs * gv[bj][0];
                    *(f32x4*)(out + off + bj * HALF + 4) = (f32x4){bf_lo(p.z), bf_hi(p.z), bf_lo(p.w), bf_hi(p.w)} + acc[ai][bj][m][1] * rs * gv[bj][1]; }
                if (m & 1) asm volatile("" ::: "memory"); }
    }
};

template <class Epi, class Sched, bool ALIGN_EPI, bool SP2>
__device__ __forceinline__ void gemm_phase(LAS unsigned char* lds, const Gemm g, const Sched& S, const Epi& E) {
    const int tid = threadIdx.x, wid = __builtin_amdgcn_readfirstlane(tid >> 6), lane = tid & 63, wr = wid >> 2, wc = wid & 3, fr = lane & 15, fq = lane >> 4;
    const int K = g.K, nt = K / BK;
    unsigned voffA[2], voffB[2];
#pragma unroll
    for (int i = 0; i < 2; ++i) { int R, C; stage_rc(tid * 16 + i * 8192, R, C); const int Rb = Epi::PERM ? ((R & ~31) + perm32(R & 31)) : R; voffA[i] = (unsigned)(R * K + C) * 2u; voffB[i] = (unsigned)(Rb * K + C) * 2u; }
    const size_t kstep = (size_t)(BK * 2);
    const size_t hstep = (size_t)HALF * K * 2;
    const size_t tstep = 2 * hstep;
    const unsigned ldsw = (unsigned)wid * 1024u;
    const int aoff = lds_byte(wr * 64 + fr, fq * 8), boff = lds_byte(wc * 32 + fr, fq * 8);
#define PG8_SA(b, h) (((b) * 2 + (h)) * HTB)
#define PG8_SB(b, h) ((4 + (b) * 2 + (h)) * HTB)
#define PG8_STAGE(bufoff, gbase, voff) do { _Pragma("unroll") for (int _i = 0; _i < 2; ++_i) \
        __builtin_amdgcn_global_load_lds((const unsigned*)((const char*)(gbase) + (voff)[_i]), (LAS unsigned*)(lds + (bufoff) + ldsw + _i * 8192), 16, 0, 0); } while (0)
#define PG8_LDA(dst, b, h) do { _Pragma("unroll") for (int m = 0; m < 4; ++m) _Pragma("unroll") for (int k = 0; k < 2; ++k) dst[m][k] = *(const LAS bf16x8*)(lds + PG8_SA(b, h) + aoff + m * 2048 + k * 1024); } while (0)
#define PG8_LDB(dst, b, h) do { _Pragma("unroll") for (int n = 0; n < 2; ++n) _Pragma("unroll") for (int k = 0; k < 2; ++k) dst[n][k] = *(const LAS bf16x8*)(lds + PG8_SB(b, h) + boff + n * 2048 + k * 1024); } while (0)
#define PG8_MMA(ai, bj, At, Bt) do { __builtin_amdgcn_s_setprio(1); _Pragma("unroll") for (int m = 0; m < 4; ++m) _Pragma("unroll") for (int n = 0; n < 2; ++n) _Pragma("unroll") for (int k = 0; k < 2; ++k) \
        acc[ai][bj][m][n] = __builtin_amdgcn_mfma_f32_16x16x32_bf16(Bt[n][k], At[m][k], acc[ai][bj][m][n], 0, 0, 0); __builtin_amdgcn_s_setprio(0); } while (0)
#define PG8_WAIT_V(n) asm volatile("s_waitcnt vmcnt(" #n ")" ::: "memory")
#define PG8_WAIT_L(n) asm volatile("s_waitcnt lgkmcnt(" #n ")" ::: "memory")
#define PG8_BAR __builtin_amdgcn_s_barrier()
#define PG8_SCHED __builtin_amdgcn_sched_barrier(0)
    Unit cur, nxt; int ui = 0;
    if (!S.next(0, cur)) return;
    f32x4 acc[2][2][4][2];
#pragma unroll
    for (int a = 0; a < 2; ++a)
#pragma unroll
        for (int b = 0; b < 2; ++b)
#pragma unroll
            for (int m = 0; m < 4; ++m)
#pragma unroll
                for (int n = 0; n < 2; ++n) acc[a][b][m][n] = (f32x4){0.f, 0.f, 0.f, 0.f};
    bf16x8 At[4][2], B0[2][2], B1[2][2];
    const char* cA = (const char*)g.A + (size_t)cur.pm * tstep + (cur.half == 2 ? hstep : 0); const char* cB = (const char*)g.Bt + (size_t)cur.pn * tstep;
    if constexpr (Epi::CONV) E.prefetch(lds, cur, 0, tid, wid);
    if constexpr (SP2) {
        PG8_STAGE(PG8_SB(0, 0), cB, voffB); PG8_STAGE(PG8_SB(0, 1), cB + hstep, voffB); PG8_STAGE(PG8_SA(0, 0), cA, voffA); PG8_STAGE(PG8_SA(0, 1), cA + hstep, voffA);
        if (wr == 1) PG8_BAR;
        PG8_WAIT_V(2); PG8_BAR;
        PG8_STAGE(PG8_SB(1, 0), cB + kstep, voffB); PG8_STAGE(PG8_SA(1, 0), cA + kstep, voffA); PG8_STAGE(PG8_SB(1, 1), cB + hstep + kstep, voffB);
        PG8_WAIT_V(6); PG8_BAR;
    } else {
        PG8_STAGE(PG8_SB(0, 0), cB, voffB); PG8_STAGE(PG8_SA(0, 0), cA, voffA); PG8_STAGE(PG8_SB(0, 1), cB + hstep, voffB); PG8_STAGE(PG8_SA(0, 1), cA + hstep, voffA);
        if (wr == 1) PG8_BAR;
        PG8_WAIT_V(4); PG8_BAR;
        PG8_STAGE(PG8_SB(1, 0), cB + kstep, voffB); PG8_STAGE(PG8_SA(1, 0), cA + kstep, voffA); PG8_STAGE(PG8_SB(1, 1), cB + hstep + kstep, voffB);
        PG8_WAIT_V(6); PG8_BAR;
    }
    for (;;) {
        const bool has_next = S.next(ui + 1, nxt);
        const char* nA = has_next ? (const char*)g.A + (size_t)nxt.pm * tstep + (nxt.half == 2 ? hstep : 0) : cA; const char* nB = has_next ? (const char*)g.Bt + (size_t)nxt.pn * tstep : cB;
        for (int t = 0; t < nt; t += 2) {
            const bool last = (t == nt - 2);
            const char* a1 = cA + (size_t)(t + 1) * kstep;
            const char* a2 = last ? nA : cA + (size_t)(t + 2) * kstep; const char* b2 = last ? nB : cB + (size_t)(t + 2) * kstep;
            const char* a3 = a2 + kstep; const char* b3 = b2 + kstep;
            if constexpr (Epi::CONV) { if (last && has_next) E.prefetch(lds, nxt, (ui + 1) & 1, tid, wid); }
            if constexpr (SP2) {
            PG8_LDB(B0, 0, 0); PG8_LDB(B1, 0, 1); PG8_SCHED; PG8_LDA(At, 0, 0); PG8_STAGE(PG8_SA(1, 1), a1 + hstep, voffA);
            PG8_WAIT_V(8); PG8_WAIT_L(0); PG8_BAR; PG8_MMA(0, 0, At, B0); PG8_MMA(0, 1, At, B1); PG8_BAR; PG8_SCHED;
            if (!cur.half) PG8_LDA(At, 0, 1); PG8_STAGE(PG8_SB(0, 0), b2, voffB); PG8_STAGE(PG8_SB(0, 1), b2 + hstep, voffB); PG8_STAGE(PG8_SA(0, 0), a2, voffA);
            PG8_WAIT_V(8); PG8_WAIT_L(0); PG8_BAR; if (!cur.half) { PG8_MMA(1, 0, At, B0); PG8_MMA(1, 1, At, B1); } PG8_BAR; PG8_SCHED;
            PG8_LDB(B0, 1, 0); PG8_LDB(B1, 1, 1); PG8_SCHED; PG8_LDA(At, 1, 0); PG8_STAGE(PG8_SA(0, 1), a2 + hstep, voffA);
            PG8_WAIT_V(8); PG8_WAIT_L(0); PG8_BAR; PG8_MMA(0, 0, At, B0); PG8_MMA(0, 1, At, B1); PG8_BAR; PG8_SCHED;
            if (!cur.half) PG8_LDA(At, 1, 1); PG8_STAGE(PG8_SB(1, 0), b3, voffB); PG8_STAGE(PG8_SB(1, 1), b3 + hstep, voffB); PG8_STAGE(PG8_SA(1, 0), a3, voffA);
            PG8_WAIT_V(8); PG8_WAIT_L(0); PG8_BAR; if (!cur.half) { PG8_MMA(1, 0, At, B0); PG8_MMA(1, 1, At, B1); } PG8_BAR; PG8_SCHED;
            } else {
            PG8_LDB(B0, 0, 0); PG8_SCHED; PG8_LDA(At, 0, 0); PG8_STAGE(PG8_SA(1, 1), a1 + hstep, voffA);
            PG8_WAIT_L(8); PG8_BAR; PG8_WAIT_L(0); PG8_MMA(0, 0, At, B0); PG8_BAR; PG8_SCHED;
            PG8_LDB(B1, 0, 1); PG8_STAGE(PG8_SB(0, 0), b2, voffB);
            PG8_BAR; PG8_WAIT_L(0); PG8_MMA(0, 1, At, B1); PG8_BAR;
            PG8_LDA(At, 0, 1); PG8_STAGE(PG8_SA(0, 0), a2, voffA);
            PG8_BAR; PG8_WAIT_L(0); PG8_MMA(1, 0, At, B0); PG8_BAR; PG8_SCHED;
            PG8_STAGE(PG8_SB(0, 1), b2 + hstep, voffB);
            PG8_WAIT_V(6); PG8_BAR; PG8_MMA(1, 1, At, B1); PG8_BAR;
            PG8_LDB(B0, 1, 0); PG8_SCHED; PG8_LDA(At, 1, 0); PG8_STAGE(PG8_SA(0, 1), a2 + hstep, voffA);
            PG8_WAIT_L(8); PG8_BAR; PG8_WAIT_L(0); PG8_MMA(0, 0, At, B0); PG8_BAR; PG8_SCHED;
            PG8_LDB(B1, 1, 1); PG8_STAGE(PG8_SB(1, 0), b3, voffB);
            PG8_BAR; PG8_WAIT_L(0); PG8_MMA(0, 1, At, B1); PG8_BAR;
            PG8_LDA(At, 1, 1); PG8_STAGE(PG8_SA(1, 0), a3, voffA);
            PG8_BAR; PG8_WAIT_L(0); PG8_MMA(1, 0, At, B0); PG8_BAR; PG8_SCHED;
            PG8_STAGE(PG8_SB(1, 1), b3 + hstep, voffB);
            PG8_WAIT_V(6); PG8_BAR; PG8_MMA(1, 1, At, B1); PG8_BAR;
            }
        }
        if constexpr (ALIGN_EPI) { if (wr == 0) PG8_BAR; }
        if constexpr (Epi::CONV) E(acc, cur, wr, wc, fr, fq, lds, ui & 1);
        else if constexpr (!Epi::AFTER_DRAIN) E(acc, cur, wr, wc, fr, fq);
        if (!has_next) break;
#pragma unroll
        for (int a = 0; a < 2; ++a)
#pragma unroll
            for (int b = 0; b < 2; ++b)
#pragma unroll
                for (int m = 0; m < 4; ++m)
#pragma unroll
                    for (int n = 0; n < 2; ++n) acc[a][b][m][n] = (f32x4){0.f, 0.f, 0.f, 0.f};
        cur = nxt; cA = nA; cB = nB; ++ui;
        if constexpr (ALIGN_EPI) { if (wr == 1) PG8_BAR; }
    }
    PG8_WAIT_V(0);
    if constexpr (!ALIGN_EPI) { if (wr == 0) PG8_BAR; }
    PG8_BAR;
    if constexpr (Epi::AFTER_DRAIN) E.fused(acc, cur, wr, wc, fr, fq, lds, wid, lane);
#undef PG8_SA
#undef PG8_SB
#undef PG8_STAGE
#undef PG8_LDA
#undef PG8_LDB
#undef PG8_MMA
#undef PG8_WAIT_V
#undef PG8_WAIT_L
#undef PG8_BAR
#undef PG8_SCHED
}
}

template <bool PERMUP, bool WTHRU = false>
__device__ __forceinline__ void p0_transpose_item(const float* W, int K, int N, bf16_t* WT, LAS float* scr, int item, int lane, const float* kgain = nullptr) {
    const int nblk = N / 64, kb = item / nblk, nb = item % nblk, k0 = 64 * kb, n0 = 64 * nb;
    int d0 = n0;
    if (PERMUP) d0 = (n0 < DFF) ? (256 * (n0 / 128) + (n0 % 128)) : (256 * ((n0 - DFF) / 128) + 128 + ((n0 - DFF) % 128));
#pragma unroll 16
    for (int i = 0; i < 64; ++i) scr[i * 65 + lane] = W[(size_t)(k0 + i) * N + n0 + lane];
    asm volatile("s_waitcnt lgkmcnt(0)" ::: "memory");
    const int c = lane & 7;
    f32x4 ga = (f32x4){1.f, 1.f, 1.f, 1.f}, gb = ga;
    if (kgain) { ga = *(const f32x4*)(kgain + k0 + 8 * c); gb = *(const f32x4*)(kgain + k0 + 8 * c + 4); }
#pragma unroll
    for (int j = 0; j < 8; ++j) { const int n = (lane >> 3) + 8 * j; const LAS float* s = scr + (8 * c) * 65 + n;
        u32x4 o; o.x = cvt_pk_bf16(s[0 * 65] * ga.x, s[1 * 65] * ga.y); o.y = cvt_pk_bf16(s[2 * 65] * ga.z, s[3 * 65] * ga.w); o.z = cvt_pk_bf16(s[4 * 65] * gb.x, s[5 * 65] * gb.y); o.w = cvt_pk_bf16(s[6 * 65] * gb.z, s[7 * 65] * gb.w);
        bf16_t* dst = WT + (size_t)(d0 + n) * K + k0 + 8 * c;
        if (WTHRU) asm volatile("global_store_dwordx4 %0, %1, off sc1\n\ts_nop 1" :: "v"(dst), "v"(o) : "memory");
        else *(u32x4*)dst = o; }
    asm volatile("s_waitcnt lgkmcnt(0)" ::: "memory");
}
__device__ __forceinline__ void row_to_bf16_rs(const float* xrow, bf16_t* orow, float* rs_out, int lane) {
    const f32x4* xr = (const f32x4*)xrow + lane;
    f32x4 v[4]; float s = 0.f;
#pragma unroll
    for (int j = 0; j < 4; ++j) { v[j] = xr[64 * j]; s += (v[j].x * v[j].x + v[j].y * v[j].y) + (v[j].z * v[j].z + v[j].w * v[j].w); }
    const float rs = 1.0f / sqrtf(wave_sum(s) * (1.f / DM) + RMS_EPS);
    u32x2* o8 = (u32x2*)orow + lane;
#pragma unroll
    for (int j = 0; j < 4; ++j) { u32x2 w; w.x = cvt_pk_bf16(v[j].x, v[j].y); w.y = cvt_pk_bf16(v[j].z, v[j].w); o8[64 * j] = w; }
    if (lane == 0) *rs_out = rs;
}

constexpr int KSTR = 136, VSTR = 216, KROWS = 208;
constexpr int ATT_VT_OFF = KROWS * KSTR * 2;
constexpr int ATT_SS_OFF = ATT_VT_OFF + 128 * VSTR * 2;
__device__ __forceinline__ void attn_unit(LAS unsigned char* lds, const bf16_t* PROJ, bf16_t* MERGED, const float* sinks, const float* g_attn, int u, int tid, int wid, int lane) {
    const int b = u >> 5, qb = u & 31;
    const int kb0 = 64 * qb - 144;
    LAS bf16_t* Ks = (LAS bf16_t*)lds;
    LAS bf16_t* Vt = (LAS bf16_t*)(lds + ATT_VT_OFF);
    LAS float* SS = (LAS float*)(lds + ATT_SS_OFF);
    const bf16_t* base = PROJ + (size_t)b * SEQ * INW;
    for (int task = tid; task < KROWS * 16; task += 512) {
        const int kr = task >> 4, cc = task & 15, tok = kb0 + kr;
        u32x4 v = *(const u32x4*)(base + (size_t)(tok < 0 ? 0 : tok) * INW + KOFF + 8 * cc);
        if (tok < 0) v = (u32x4){0u, 0u, 0u, 0u};
        *(LAS u32x4*)(Ks + kr * KSTR + 8 * cc) = v;
    }
    for (int task = tid; task < (KROWS / 2) * 16; task += 512) {
        const int kp = task % (KROWS / 2), dc = task / (KROWS / 2), tok = kb0 + 2 * kp;
        const int tokc = tok < 0 ? 0 : tok;
        u32x4 a0 = *(const u32x4*)(base + (size_t)tokc * INW + VOFF + 8 * dc), a1 = *(const u32x4*)(base + (size_t)(tokc + 1) * INW + VOFF + 8 * dc);
        if (tok < 0) { a0 = (u32x4){0u, 0u, 0u, 0u}; a1 = a0; }
#pragma unroll
        for (int e = 0; e < 8; ++e) {
            const unsigned w0 = a0[e >> 1], w1 = a1[e >> 1];
            const unsigned lo = (e & 1) ? (w0 >> 16) : (w0 & 0xffffu), hi = (e & 1) ? (w1 & 0xffff0000u) : (w1 << 16);
            *(LAS unsigned*)(Vt + (8 * dc + e) * VSTR + 2 * kp) = lo | hi;
        }
    }
    __syncthreads();
    const int h = wid, kvh = h >> 2, qq = lane & 15, g = lane >> 4;
    const float slope2 = fast_exp2(-(float)(h + 1)) * LOG2E, sink2 = sinks[h] * LOG2E;
    f32x4 O[4][4];
#pragma unroll
    for (int i = 0; i < 4; ++i) {
        const int tq = 64 * qb + 16 * i + qq;
        const bf16_t* qp = base + (size_t)tq * INW + h * 64 + 8 * g;
        const bf16x8 qf0 = *(const bf16x8*)qp, qf1 = *(const bf16x8*)(qp + 32);
        f32x4 S[9];
#pragma unroll
        for (int jb = 0; jb < 9; ++jb) {
            const LAS bf16_t* kp = Ks + (16 * i + 16 + 16 * jb + qq) * KSTR + kvh * 64 + 8 * g;
            const bf16x8 k0 = *(const LAS bf16x8*)kp, k1 = *(const LAS bf16x8*)(kp + 32);
            f32x4 s = (f32x4){0.f, 0.f, 0.f, 0.f};
            s = __builtin_amdgcn_mfma_f32_16x16x32_bf16(k0, qf0, s, 0, 0, 0);
            s = __builtin_amdgcn_mfma_f32_16x16x32_bf16(k1, qf1, s, 0, 0, 0);
            S[jb] = s;
        }
        float mx = sink2;
#pragma unroll
        for (int jb = 0; jb < 9; ++jb)
#pragma unroll
            for (int r = 0; r < 4; ++r) {
                const int kk = 4 * g + r, dist = 128 - 16 * jb + qq - kk, ktok = 64 * qb + 16 * i - 128 + 16 * jb + kk;
                const bool valid = (dist >= 0) && (dist < 128) && (ktok >= 0);
                float l = S[jb][r] * (0.125f * LOG2E) - slope2 * (float)dist;
                l = valid ? l : -INFINITY;
                S[jb][r] = l; mx = fmaxf(mx, l);
            }
        mx = fmaxf(mx, __shfl_xor(mx, 16)); mx = fmaxf(mx, __shfl_xor(mx, 32));
        float den = 0.f;
#pragma unroll
        for (int jb = 0; jb < 9; ++jb)
#pragma unroll
            for (int r = 0; r < 4; ++r) { const float p = fast_exp2(S[jb][r] - mx); den += p; S[jb][r] = p; }
        den += __shfl_xor(den, 16); den += __shfl_xor(den, 32);
        den += fast_exp2(sink2 - mx);
        const float inv = fast_rcp(den);
#pragma unroll
        for (int db = 0; db < 4; ++db) O[i][db] = (f32x4){0.f, 0.f, 0.f, 0.f};
#pragma unroll
        for (int ks2 = 0; ks2 < 5; ++ks2) {
            u32x4 pw;
            if (ks2 == 0) { pw.x = 0u; pw.y = 0u; } else { pw.x = cvt_pk_bf16(S[2 * ks2 - 1][0], S[2 * ks2 - 1][1]); pw.y = cvt_pk_bf16(S[2 * ks2 - 1][2], S[2 * ks2 - 1][3]); }
            pw.z = cvt_pk_bf16(S[2 * ks2][0], S[2 * ks2][1]); pw.w = cvt_pk_bf16(S[2 * ks2][2], S[2 * ks2][3]);
            const bf16x8 pf = __builtin_bit_cast(bf16x8, pw);
#pragma unroll
            for (int db = 0; db < 4; ++db) {
                const LAS bf16_t* vp = Vt + (kvh * 64 + 16 * (qq >> 2) + 4 * db + (qq & 3)) * VSTR + 16 * i + 32 * ks2 + 4 * g;
                const u32x2 lo = *(const LAS u32x2*)vp, hi = *(const LAS u32x2*)(vp + 16);
                const u32x4 vw = (u32x4){lo.x, lo.y, hi.x, hi.y};
                O[i][db] = __builtin_amdgcn_mfma_f32_16x16x32_bf16(__builtin_bit_cast(bf16x8, vw), pf, O[i][db], 0, 0, 0);
            }
        }
        float ssq = 0.f;
#pragma unroll
        for (int db = 0; db < 4; ++db) { O[i][db] = O[i][db] * inv; const f32x4 o = O[i][db]; ssq += (o.x * o.x + o.y * o.y) + (o.z * o.z + o.w * o.w); }
        ssq += __shfl_xor(ssq, 16); ssq += __shfl_xor(ssq, 32);
        if (g == 0) SS[(16 * i + qq) * 8 + h] = ssq;
    }
    __syncthreads();
#pragma unroll
    for (int i = 0; i < 4; ++i) {
        const f32x4 s0 = *(const LAS f32x4*)(SS + (16 * i + qq) * 8), s1 = *(const LAS f32x4*)(SS + (16 * i + qq) * 8 + 4);
        const float tot = (s0.x + s0.y) + (s0.z + s0.w) + (s1.x + s1.y) + (s1.z + s1.w);
        const float rs = __builtin_amdgcn_rsqf(tot * (1.f / 512.f) + RMS_EPS);
        bf16_t* orow = MERGED + (size_t)(b * SEQ + 64 * qb + 16 * i + qq) * DM + h * 64 + 16 * g;
        unsigned pk[8];
#pragma unroll
        for (int db = 0; db < 4; ++db) {
            const f32x4 gg = *(const f32x4*)(g_attn + h * 64 + 16 * g + 4 * db); const f32x4 o = O[i][db];
            pk[2 * db] = cvt_pk_bf16(o.x * rs * gg.x, o.y * rs * gg.y); pk[2 * db + 1] = cvt_pk_bf16(o.z * rs * gg.z, o.w * rs * gg.w);
        }
        *(u32x4*)orow = (u32x4){pk[0], pk[1], pk[2], pk[3]}; *(u32x4*)(orow + 8) = (u32x4){pk[4], pk[5], pk[6], pk[7]};
    }
    __syncthreads();
}

__device__ __forceinline__ void lru_unit(LAS unsigned char* lds, const bf16_t* PROJ, const bf16_t* WaT, const bf16_t* WxT, const float* convw, const float* convb, const float* ba, const float* bx, const float* sp,
                                         float* SUMM, unsigned* FLAG, const float* g_lru, bf16_t* MERGED, bool xl, int u, int tid, int wid, int lane) {
    const int b = u >> 5, c = u & 31, hd = wid, fr = lane & 15, g = lane >> 4;
    constexpr int HSTR = 520;
    LAS bf16_t* HLs = (LAS bf16_t*)lds; LAS bf16_t* ACs = (LAS bf16_t*)(lds + 64 * HSTR * 2);
    LAS float* C = (LAS float*)(lds + 2 * 64 * HSTR * 2);
    LAS float* Hs = C + 4096;
    C[tid] = convw[tid]; C[512 + tid] = convw[512 + tid]; C[1024 + tid] = convw[1024 + tid]; C[1536 + tid] = convw[1536 + tid];
    C[2048 + tid] = convb[tid]; C[2560 + tid] = ba[tid]; C[3072 + tid] = bx[tid]; C[3584 + tid] = sp[tid];
    bf16x8 wa[4][2], wx[4][2];
#pragma unroll
    for (int ob = 0; ob < 4; ++ob)
#pragma unroll
        for (int ks = 0; ks < 2; ++ks) {
            const size_t off = (size_t)(hd * 64 + 16 * (fr >> 2) + 4 * ob + (fr & 3)) * 64 + 16 * g + 8 * ks;
            wa[ob][ks] = *(const bf16x8*)(WaT + off); wx[ob][ks] = *(const bf16x8*)(WxT + off);
        }
    __syncthreads();
    f32x4 cH[4], cA[4];
#pragma unroll
    for (int ob = 0; ob < 4; ++ob) { cH[ob] = (f32x4){0.f, 0.f, 0.f, 0.f}; cA[ob] = (f32x4){1.f, 1.f, 1.f, 1.f}; }
    const int chb = hd * 64 + 16 * g;
    const bf16_t* lxb = PROJ + (size_t)b * SEQ * INW + LXOFF + chb;
#pragma unroll 1
    for (int tb = 0; tb < 4; ++tb) {
        const int t = 64 * c + 16 * tb + fr;
        u32x4 raw[4][2];
#pragma unroll
        for (int k = 0; k < 4; ++k) {
            const int tt = t - 3 + k, ttc = tt < 0 ? 0 : tt;
            raw[k][0] = *(const u32x4*)(lxb + (size_t)ttc * INW); raw[k][1] = *(const u32x4*)(lxb + (size_t)ttc * INW + 8);
            if (tt < 0) { raw[k][0] = (u32x4){0u, 0u, 0u, 0u}; raw[k][1] = raw[k][0]; }
        }
        float xc[16];
#pragma unroll
        for (int q = 0; q < 4; ++q) {
            f32x4 a = *(const LAS f32x4*)(C + 2048 + chb + 4 * q);
#pragma unroll
            for (int k = 0; k < 4; ++k) {
                const f32x4 w = *(const LAS f32x4*)(C + k * 512 + chb + 4 * q);
                const unsigned r0 = raw[k][q >> 1][2 * (q & 1)], r1 = raw[k][q >> 1][2 * (q & 1) + 1];
                a = a + w * (f32x4){bf_lo(r0), bf_hi(r0), bf_lo(r1), bf_hi(r1)};
            }
            xc[4 * q] = a.x; xc[4 * q + 1] = a.y; xc[4 * q + 2] = a.z; xc[4 * q + 3] = a.w;
        }
        bf16x8 xf[2];
#pragma unroll
        for (int ks = 0; ks < 2; ++ks) {
            u32x4 w; w.x = cvt_pk_bf16(xc[8 * ks], xc[8 * ks + 1]); w.y = cvt_pk_bf16(xc[8 * ks + 2], xc[8 * ks + 3]);
            w.z = cvt_pk_bf16(xc[8 * ks + 4], xc[8 * ks + 5]); w.w = cvt_pk_bf16(xc[8 * ks + 6], xc[8 * ks + 7]);
            xf[ks] = __builtin_bit_cast(bf16x8, w);
        }
        const size_t row = (size_t)b * SEQ + t;
#pragma unroll
        for (int ob = 0; ob < 4; ++ob) {
            f32x4 R = (f32x4){0.f, 0.f, 0.f, 0.f}, I = R;
            R = __builtin_amdgcn_mfma_f32_16x16x32_bf16(wa[ob][0], xf[0], R, 0, 0, 0); R = __builtin_amdgcn_mfma_f32_16x16x32_bf16(wa[ob][1], xf[1], R, 0, 0, 0);
            I = __builtin_amdgcn_mfma_f32_16x16x32_bf16(wx[ob][0], xf[0], I, 0, 0, 0); I = __builtin_amdgcn_mfma_f32_16x16x32_bf16(wx[ob][1], xf[1], I, 0, 0, 0);
            const f32x4 bav = *(const LAS f32x4*)(C + 2560 + chb + 4 * ob), bxv = *(const LAS f32x4*)(C + 3072 + chb + 4 * ob), spv = *(const LAS f32x4*)(C + 3584 + chb + 4 * ob);
            float hl[4], ac[4];
            f32x4 av4, uv4;
            {
                const f32x4 tr = (R + bav) * (-LOG2E), ti = (I + bxv) * (-LOG2E);
                f32x4 er, ei; er.x = fast_exp2(tr.x); er.y = fast_exp2(tr.y); er.z = fast_exp2(tr.z); er.w = fast_exp2(tr.w);
                ei.x = fast_exp2(ti.x); ei.y = fast_exp2(ti.y); ei.z = fast_exp2(ti.z); ei.w = fast_exp2(ti.w);
                const f32x4 dr = er + 1.0f, di = ei + 1.0f;
                f32x4 rg, ig; rg.x = fast_rcp(dr.x); rg.y = fast_rcp(dr.y); rg.z = fast_rcp(dr.z); rg.w = fast_rcp(dr.w);
                ig.x = fast_rcp(di.x); ig.y = fast_rcp(di.y); ig.z = fast_rcp(di.z); ig.w = fast_rcp(di.w);
                const f32x4 la2 = rg * spv * (-8.0f * LOG2E);
                f32x4 a4; a4.x = fast_exp2(la2.x); a4.y = fast_exp2(la2.y); a4.z = fast_exp2(la2.z); a4.w = fast_exp2(la2.w);
                f32x4 om = 1.0f - a4 * a4;
                om.x = fmaxf(om.x, 0.f); om.y = fmaxf(om.y, 0.f); om.z = fmaxf(om.z, 0.f); om.w = fmaxf(om.w, 0.f);
                f32x4 sq; sq.x = __builtin_amdgcn_sqrtf(om.x); sq.y = __builtin_amdgcn_sqrtf(om.y); sq.z = __builtin_amdgcn_sqrtf(om.z); sq.w = __builtin_amdgcn_sqrtf(om.w);
                const f32x4 xv = (f32x4){xc[4 * ob], xc[4 * ob + 1], xc[4 * ob + 2], xc[4 * ob + 3]};
                av4 = a4; uv4 = sq * ig * xv;
            }
            float av[4] = {av4.x, av4.y, av4.z, av4.w}, uv[4] = {uv4.x, uv4.y, uv4.z, uv4.w};
#define LRU_SCAN_STEP(SH) asm volatile("s_nop 1\n\t" \
                "v_fmac_f32_dpp %0, %0, %4 row_shr:" #SH " row_mask:0xf bank_mask:0xf\n\tv_fmac_f32_dpp %1, %1, %5 row_shr:" #SH " row_mask:0xf bank_mask:0xf\n\t" \
                "v_fmac_f32_dpp %2, %2, %6 row_shr:" #SH " row_mask:0xf bank_mask:0xf\n\tv_fmac_f32_dpp %3, %3, %7 row_shr:" #SH " row_mask:0xf bank_mask:0xf\n\t" \
                "v_mul_f32_dpp %4, %4, %4 row_shr:" #SH " row_mask:0xf bank_mask:0xf\n\tv_mul_f32_dpp %5, %5, %5 row_shr:" #SH " row_mask:0xf bank_mask:0xf\n\t" \
                "v_mul_f32_dpp %6, %6, %6 row_shr:" #SH " row_mask:0xf bank_mask:0xf\n\tv_mul_f32_dpp %7, %7, %7 row_shr:" #SH " row_mask:0xf bank_mask:0xf\n\ts_nop 1" \
                : "+v"(uv[0]), "+v"(uv[1]), "+v"(uv[2]), "+v"(uv[3]), "+v"(av[0]), "+v"(av[1]), "+v"(av[2]), "+v"(av[3]))
            LRU_SCAN_STEP(1); LRU_SCAN_STEP(2); LRU_SCAN_STEP(4); LRU_SCAN_STEP(8);
#undef LRU_SCAN_STEP
#pragma unroll
            for (int r = 0; r < 4; ++r) {
                hl[r] = uv[r] + av[r] * cH[ob][r]; ac[r] = av[r] * cA[ob][r];
                cH[ob][r] = __shfl(hl[r], (lane & 48) | 15); cA[ob][r] = __shfl(ac[r], (lane & 48) | 15);
            }
            { LAS bf16_t* hr = HLs + (16 * tb + fr) * HSTR + chb + 4 * ob; LAS bf16_t* ar = ACs + (16 * tb + fr) * HSTR + chb + 4 * ob;
              *(LAS u32x2*)hr = (u32x2){cvt_pk_bf16(hl[0], hl[1]), cvt_pk_bf16(hl[2], hl[3])}; *(LAS u32x2*)ar = (u32x2){cvt_pk_bf16(ac[0], ac[1]), cvt_pk_bf16(ac[2], ac[3])}; }
        }
    }
    const int lane_t = (int)__builtin_amdgcn_mbcnt_hi(~0u, __builtin_amdgcn_mbcnt_lo(~0u, 0u));
    const int tid_t = wid * 64 + lane_t, fr_t = lane_t & 15, chb_t = hd * 64 + 16 * (lane_t >> 4);
    if (fr_t == 0) {
        unsigned* sa = (unsigned*)(SUMM + ((size_t)(b * 32 + c) * 2 + 0) * 512 + chb_t); unsigned* sh = sa + 512;
        if (xl) {
#pragma unroll
            for (int ob = 0; ob < 4; ++ob) { *(f32x4*)(sa + 4 * ob) = cA[ob]; *(f32x4*)(sh + 4 * ob) = cH[ob]; }
        } else {
#pragma unroll
        for (int ob = 0; ob < 4; ++ob)
#pragma unroll
            for (int r = 0; r < 4; ++r) {
                __hip_atomic_store(sa + 4 * ob + r, __float_as_uint(cA[ob][r]), __ATOMIC_RELAXED, __HIP_MEMORY_SCOPE_AGENT);
                __hip_atomic_store(sh + 4 * ob + r, __float_as_uint(cH[ob][r]), __ATOMIC_RELAXED, __HIP_MEMORY_SCOPE_AGENT);
            }
        }
    }
    asm volatile("s_waitcnt vmcnt(0) lgkmcnt(0)" ::: "memory");
    __syncthreads();
    if (tid_t == 0) __hip_atomic_store(FLAG + 16 * u, 1u, __ATOMIC_RELAXED, __HIP_MEMORY_SCOPE_AGENT);
    if (tid_t < c) {
        unsigned sp = 0;
        while (__hip_atomic_load(FLAG + 16 * (b * 32 + tid_t), __ATOMIC_RELAXED, __HIP_MEMORY_SCOPE_AGENT) == 0u) { __builtin_amdgcn_s_sleep(2); if (++sp > (1u << 22)) break; }
    }
    __syncthreads();
    {
        float H = 0.f;
        for (int c0 = 0; c0 < c; c0 += 16) {
            float sa[16], sh[16];
#pragma unroll
            for (int q = 0; q < 16; ++q) { const int cp = (c0 + q < c) ? (c0 + q) : 0; const unsigned* sp_ = (const unsigned*)SUMM + ((size_t)(b * 32 + cp) * 2) * 512 + tid_t;
                if (xl) { sa[q] = __uint_as_float(sp_[0]); sh[q] = __uint_as_float(sp_[512]); }
                else { sa[q] = __uint_as_float(__hip_atomic_load(sp_, __ATOMIC_RELAXED, __HIP_MEMORY_SCOPE_AGENT)); sh[q] = __uint_as_float(__hip_atomic_load(sp_ + 512, __ATOMIC_RELAXED, __HIP_MEMORY_SCOPE_AGENT)); } }
#pragma unroll
            for (int q = 0; q < 16; ++q) if (c0 + q < c) H = sa[q] * H + sh[q];
        }
        Hs[tid_t] = H;
    }
    __syncthreads();
    {
        const f32x4 H0 = *(const LAS f32x4*)(Hs + 8 * lane_t), H1 = *(const LAS f32x4*)(Hs + 8 * lane_t + 4);
        const f32x4 g0 = *(const f32x4*)(g_lru + 8 * lane_t), g1 = *(const f32x4*)(g_lru + 8 * lane_t + 4);
#pragma unroll
        for (int j = 0; j < 8; ++j) {
            const int tk = 8 * wid + j; const size_t row = (size_t)b * SEQ + 64 * c + tk;
            const u32x4 hlw = *(const LAS u32x4*)(HLs + tk * HSTR + 8 * lane_t), acw = *(const LAS u32x4*)(ACs + tk * HSTR + 8 * lane_t), lgw = *(const u32x4*)(PROJ + row * INW + LGOFF + 8 * lane_t);
            const f32x4 hl0 = (f32x4){bf_lo(hlw.x), bf_hi(hlw.x), bf_lo(hlw.y), bf_hi(hlw.y)}, hl1 = (f32x4){bf_lo(hlw.z), bf_hi(hlw.z), bf_lo(hlw.w), bf_hi(hlw.w)};
            const f32x4 ac0 = (f32x4){bf_lo(acw.x), bf_hi(acw.x), bf_lo(acw.y), bf_hi(acw.y)}, ac1 = (f32x4){bf_lo(acw.z), bf_hi(acw.z), bf_lo(acw.w), bf_hi(acw.w)};
            const f32x4 lg0 = (f32x4){bf_lo(lgw.x), bf_hi(lgw.x), bf_lo(lgw.y), bf_hi(lgw.y)}, lg1 = (f32x4){bf_lo(lgw.z), bf_hi(lgw.z), bf_lo(lgw.w), bf_hi(lgw.w)};
            const f32x4 v0 = (hl0 + ac0 * H0) * gelu_tanh4(lg0), v1 = (hl1 + ac1 * H1) * gelu_tanh4(lg1);
            const f32x4 q = v0 * v0 + v1 * v1;
            const float rs = __builtin_amdgcn_rsqf(wave_sum((q.x + q.y) + (q.z + q.w)) * (1.f / 512.f) + RMS_EPS);
            const f32x4 o0 = v0 * rs * g0, o1 = v1 * rs * g1;
            u32x4 w;
            w.x = cvt_pk_bf16(o0.x, o0.y); w.y = cvt_pk_bf16(o0.z, o0.w); w.z = cvt_pk_bf16(o1.x, o1.y); w.w = cvt_pk_bf16(o1.z, o1.w);
            *(u32x4*)(MERGED + row * DM + 512 + 8 * lane_t) = w;
        }
    }
    __syncthreads();
}

__device__ __forceinline__ void lru_final_unit(LAS unsigned char* lds, const bf16_t* PROJ, const bf16_t* HL, const bf16_t* ACUM, const float* SUMM, const float* g_lru, bf16_t* MERGED,
                                               int u, int tid, int wid, int lane) {
    const int b = u >> 5, c = u & 31;
    LAS float* Hs = (LAS float*)lds;
    {
        float H = 0.f;
        for (int c0 = 0; c0 < c; c0 += 16) {
            float sa[16], sh[16];
#pragma unroll
            for (int q = 0; q < 16; ++q) { const int cp = (c0 + q < c) ? (c0 + q) : 0; const float* s = SUMM + ((size_t)(b * 32 + cp) * 2) * 512 + tid; sa[q] = s[0]; sh[q] = s[512]; }
#pragma unroll
            for (int q = 0; q < 16; ++q) if (c0 + q < c) H = sa[q] * H + sh[q];
        }
        Hs[tid] = H;
    }
    __syncthreads();
    const f32x4 H0 = *(const LAS f32x4*)(Hs + 8 * lane), H1 = *(const LAS f32x4*)(Hs + 8 * lane + 4);
    const f32x4 g0 = *(const f32x4*)(g_lru + 8 * lane), g1 = *(const f32x4*)(g_lru + 8 * lane + 4);
#pragma unroll
    for (int j = 0; j < 8; ++j) {
        const size_t row = (size_t)b * SEQ + 64 * c + 8 * wid + j;
        const u32x4 hlw = *(const u32x4*)(HL + row * 512 + 8 * lane), acw = *(const u32x4*)(ACUM + row * 512 + 8 * lane), lgw = *(const u32x4*)(PROJ + row * INW + LGOFF + 8 * lane);
        float v[8]; float ssq = 0.f;
#pragma unroll
        for (int e = 0; e < 8; ++e) {
            const unsigned hw = hlw[e >> 1], aw = acw[e >> 1], gw = lgw[e >> 1];
            const float hl = (e & 1) ? bf_hi(hw) : bf_lo(hw), ac = (e & 1) ? bf_hi(aw) : bf_lo(aw), lg = (e & 1) ? bf_hi(gw) : bf_lo(gw);
            const float Hc = e < 4 ? H0[e & 3] : H1[e & 3];
            const float hv = hl + ac * Hc;
            v[e] = hv * gelu_tanh(lg); ssq += v[e] * v[e];
        }
        const float rs = 1.0f / sqrtf(wave_sum(ssq) * (1.f / 512.f) + RMS_EPS);
        u32x4 w;
        w.x = cvt_pk_bf16(v[0] * rs * g0.x, v[1] * rs * g0.y); w.y = cvt_pk_bf16(v[2] * rs * g0.z, v[3] * rs * g0.w);
        w.z = cvt_pk_bf16(v[4] * rs * g1.x, v[5] * rs * g1.y); w.w = cvt_pk_bf16(v[6] * rs * g1.z, v[7] * rs * g1.w);
        *(u32x4*)(MERGED + row * DM + 512 + 8 * lane) = w;
    }
    __syncthreads();
}

#define XB_TMO      128
#define XB_XCNT(j)  (256  + 64 * (j))
#define XB_XSUB(j)  (1280 + 64 * (j))
#define XB_XGEN(j)  (2304 + 64 * (j))
#define XB_TOP      3328
#define XB_TOPGEN   3392
#define XCD_BAR_WORDS 3456
#define XB_SPIN_CAP (1u << 18)
__device__ __forceinline__ unsigned xb_ld(unsigned* p)              { return __hip_atomic_load(p, __ATOMIC_RELAXED, __HIP_MEMORY_SCOPE_AGENT); }
__device__ __forceinline__ unsigned xb_add(unsigned* p, unsigned v) { return __hip_atomic_fetch_add(p, v, __ATOMIC_RELAXED, __HIP_MEMORY_SCOPE_AGENT); }
__device__ __forceinline__ unsigned xb_xcc_id() { return (unsigned)__builtin_amdgcn_s_getreg((3 << 11) | 20) & 0xFu; }
#define XB_SPIN(cond, bar) do { unsigned _sp = 0; while (cond) { __builtin_amdgcn_s_sleep(1); \
    if ((++_sp & 255u) == 0u) { if (xb_ld(&(bar)[XB_TMO])) break; if (_sp > XB_SPIN_CAP) { atomicAdd(&(bar)[XB_TMO], 1u); break; } } } } while (0)
#define SEAM(k) SEAM2(k, (k) + 1)
struct XcdBarrier { unsigned* bar; unsigned x; volatile LAS unsigned* st; };
__device__ __forceinline__ XcdBarrier xcd_barrier_post(unsigned* bar, volatile LAS unsigned* st) {
    XcdBarrier b; b.bar = bar; b.x = xb_xcc_id(); b.st = st;
    if (threadIdx.x == 0) st[2] = xb_add(&bar[XB_XCNT(b.x)], 1u);
    return b;
}
__device__ __forceinline__ void xcd_barrier_complete(unsigned* bar, unsigned x, unsigned& nloc, unsigned& nx) {
    const unsigned G = gridDim.x * gridDim.y * gridDim.z;
    unsigned sum, cnt, mine, sp = 0u;
    for (;;) {
        sum = 0u; cnt = 0u; mine = 0u;
#pragma unroll
        for (unsigned j = 0; j < 16; ++j) { const unsigned c = xb_ld(&bar[XB_XCNT(j)]); sum += c; cnt += (c > 0u) ? 1u : 0u; mine = (j == x) ? c : mine; }
        if (sum == G) break;
        __builtin_amdgcn_s_sleep(1);
        if ((++sp & 255u) == 0u) { if (xb_ld(&bar[XB_TMO])) break; if (sp > XB_SPIN_CAP) { atomicAdd(&bar[XB_TMO], 1u); break; } }
    }
    nloc = mine > 0u ? mine : 1u; nx = cnt > 0u ? cnt : 1u;
}
__device__ __forceinline__ void xcd_barrier(const XcdBarrier& b) {
    asm volatile("s_waitcnt vmcnt(0)" ::: "memory");
    __syncthreads();
    if (threadIdx.x == 0) {
        unsigned* bar = b.bar;
        __builtin_amdgcn_s_waitcnt(0);
        unsigned nloc = b.st[0], nx = b.st[1];
        if (nloc == 0u) { xcd_barrier_complete(bar, b.x, nloc, nx); b.st[0] = nloc; b.st[1] = nx; }
        const unsigned old = xb_add(&bar[XB_XSUB(b.x)], 1u);
        const unsigned gen = old / nloc;
        if (old + 1u == (gen + 1u) * nloc) {
            __builtin_amdgcn_fence(__ATOMIC_RELEASE, "agent");
            asm volatile("s_waitcnt vmcnt(0)" ::: "memory");
            const unsigned og = xb_add(&bar[XB_TOP], 1u);
            const unsigned tg = og / nx;
            if (og + 1u == (tg + 1u) * nx) xb_add(&bar[XB_TOPGEN], 1u);
            else XB_SPIN(xb_ld(&bar[XB_TOPGEN]) == tg, bar);
            __builtin_amdgcn_fence(__ATOMIC_ACQUIRE, "agent");
            xb_add(&bar[XB_XGEN(b.x)], 1u);
            asm volatile("s_waitcnt vmcnt(0)" ::: "memory");
        } else {
            XB_SPIN(xb_ld(&bar[XB_XGEN(b.x)]) == gen, bar);
            __builtin_amdgcn_fence(__ATOMIC_ACQUIRE, "agent");
            asm volatile("s_waitcnt vmcnt(0)" ::: "memory");
        }
    }
    __syncthreads();
}

#define XL_SUB(j) (3456 + 32 * (j))
#define XL_GEN(j) (3456 + 256 + 32 * (j))
__device__ __forceinline__ void xcc_local_barrier(const XcdBarrier& b) {
    asm volatile("s_waitcnt vmcnt(0)" ::: "memory");
    __syncthreads();
    if (threadIdx.x == 0) {
        unsigned* bar = b.bar;
        __builtin_amdgcn_s_waitcnt(0);
        const unsigned nloc = b.st[0];
        const unsigned old = xb_add(&bar[XL_SUB(b.x)], 1u);
        const unsigned gen = old / nloc;
        if (old + 1u == (gen + 1u) * nloc) xb_add(&bar[XL_GEN(b.x)], 1u);
        else XB_SPIN(xb_ld(&bar[XL_GEN(b.x)]) == gen, bar);
        __builtin_amdgcn_fence(__ATOMIC_ACQUIRE, "agent");
        asm volatile("s_waitcnt vmcnt(0)" ::: "memory");
    }
    __syncthreads();
}

struct Args { const float* in[21]; float* out; unsigned char* ws; int ph_lo, ph_hi; };
constexpr int N_PHASES = 10;

__global__ void __launch_bounds__(512, 2) mk_fwd(Args a) {
    extern __shared__ __attribute__((aligned(16))) unsigned char lds_raw[];
    LAS unsigned char* lds = (LAS unsigned char*)lds_raw;
    const int tid = threadIdx.x, lane = tid & 63, wid = __builtin_amdgcn_readfirstlane(tid >> 6);
    const int G = gridDim.x, bid = blockIdx.x;
    const int gw = bid * 8 + wid, NGW = G * 8;
    unsigned char* ws = a.ws;
    const float* x = a.in[0];
    bf16_t* WinT = (bf16_t*)(ws + WS_WIN); bf16_t* WoutT = (bf16_t*)(ws + WS_WOUT); bf16_t* WupT = (bf16_t*)(ws + WS_WUP); bf16_t* WdnT = (bf16_t*)(ws + WS_WDN);
    bf16_t* WaT = (bf16_t*)(ws + WS_WAT); bf16_t* WxT = WaT + 8 * 64 * 64; float* SP = (float*)(ws + WS_WAT + 131072);
    float* SUMM = (float*)(ws + WS_SUMM);
    bf16_t* HN = (bf16_t*)(ws + WS_HN); bf16_t* PROJ = (bf16_t*)(ws + WS_R1); float* Y = (float*)(ws + WS_R1);
    bf16_t* MERGED = (bf16_t*)(ws + WS_MERGED); bf16_t* HL = (bf16_t*)(ws + WS_HL); bf16_t* ACUM = (bf16_t*)(ws + WS_ACUM);
    bf16_t* GB = (bf16_t*)(ws + WS_G); bf16_t* EDGE = (bf16_t*)(ws + WS_EDGE);
    float* RS1 = (float*)(ws + WS_XB + 3 * M * 4 * 4); float* RS2 = RS1 + M;
    float* out = a.out; bf16_t* X1B = (bf16_t*)(ws + WS_MERGED);
    unsigned* XB0 = (unsigned*)(ws + WS_XB); unsigned* XB1 = XB0 + M * 4; unsigned* XB2 = XB1 + M * 4;
    unsigned* WUPCNT = (unsigned*)ws + 4032;
    unsigned* CNT0 = (unsigned*)(ws + 16384); unsigned* CNT1 = CNT0 + 64 * 64; unsigned* CNT2 = CNT1 + 64 * 64; unsigned* CNT3 = CNT2 + 64 * 64; unsigned* FLAGS = CNT3 + 64 * 64;
    const int lo = a.ph_lo, hi = a.ph_hi;
    volatile LAS unsigned* MISC = (volatile LAS unsigned*)(lds + LDS_BYTES - 256);
    if (tid < 32) MISC[tid] = 0u;
    __syncthreads();
    XcdBarrier bar; bar.bar = (unsigned*)ws; bar.x = 0; bar.st = MISC + 8;
    if (hi - lo > 1) bar = xcd_barrier_post((unsigned*)ws, MISC + 8);
#ifndef PH_MASK
#define PH_MASK 0x3ff
#endif
#define IN(k) (((PH_MASK >> (k)) & 1) && lo <= (k) && (k) < hi)
#ifndef PROBE_DUP
#define PROBE_DUP 0x0
#endif
#define REP(k) for (int rep_ = 0; rep_ < ((((PROBE_DUP) >> (k)) & 1) ? 3 : 1); ++rep_)
#ifndef PROBE_SYNC
#define PROBE_SYNC 0
#endif
#define SEAM2(k, k2) do { if (IN(k) && IN(k2)) { xcd_barrier(bar); if (PROBE_SYNC && (k) == 0) for (int q_ = 0; q_ < 10; ++q_) xcd_barrier(bar); } } while (0)

    if (IN(0)) REP(0) {
        LAS float* scr = (LAS float*)(lds + wid * 16640);
        constexpr int I_IN = (DM / 64) * (INW / 64), I_OUT = (DM / 64) * (DM / 64), I_DN = (DFF / 64) * (DM / 64);
        for (int it = gw; it < I_IN + I_OUT + I_DN; it += NGW) {
            int r = it;
            if (r < I_IN) { p0_transpose_item<false>(a.in[2], DM, INW, WinT, scr, r, lane, a.in[1]); continue; } r -= I_IN;
            if (r < I_OUT) { p0_transpose_item<false>(a.in[13], DM, DM, WoutT, scr, r, lane); continue; } r -= I_OUT;
            p0_transpose_item<false>(a.in[19], DFF, DM, WdnT, scr, r, lane);
        }
        for (int i = bid * 512 + tid; i < 2 * 8 * 64 * 64; i += G * 512) {
            const int mat = i >> 15, r = i & 32767, hh = r >> 12, o = (r >> 6) & 63, ii = r & 63;
            const float v = (mat ? a.in[8] : a.in[6])[(hh * 64 + ii) * 64 + o];
            (mat ? WxT : WaT)[r] = (bf16_t)(cvt_pk_bf16(v, 0.f) & 0xffffu);
        }
        for (int i = bid * 512 + tid; i < 512; i += G * 512) SP[i] = log1pf(expf(-a.in[10][i]));
        for (int m = gw; m < M; m += NGW) row_to_bf16_rs(x + (size_t)m * DM, HN + (size_t)m * DM, RS1 + m, lane);
        __syncthreads();
    }
    SEAM(0);
    int vb = bid; bool xlocal = false;
    if (hi - lo > 1) {
        if (tid == 0) {
            bool ok = (G == 256);
            for (unsigned j = 0; j < 16; ++j) { const unsigned cn = xb_ld(&bar.bar[XB_XCNT(j)]); ok = ok && (cn == (j < 8 ? (unsigned)(G / 8) : 0u)); }
            MISC[3 + 8] = ok ? 1u : 0u;
        }
        __syncthreads();
        xlocal = MISC[3 + 8] != 0u;
        if (xlocal) vb = (int)MISC[2 + 8] * 8 + (int)bar.x;
    }
    vb = __builtin_amdgcn_readfirstlane(vb);
#define SEAML(k, k2) do { if (IN(k) && IN(k2)) { if (xlocal) xcc_local_barrier(bar); else xcd_barrier(bar); } } while (0)
    if (IN(1)) REP(1) {
        pg8::Gemm g{HN, WinT, M, INW, DM}; pg8::StaticOrder S; S.init(M, INW, G, vb);
        pg8::EpiBf16 E{PROJ, INW, RS1};
        pg8::gemm_phase<pg8::EpiBf16, pg8::StaticOrder, true, true>(lds, g, S, E);
        {
            constexpr int NU = (M / 256) * (INW / 256);
            const bool split = (G < NU) && (2 * G > NU);
            const int f0 = split ? (NU - G) : 0, nf = G - f0;
            if (vb >= f0) {
                LAS float* scr = (LAS float*)(lds + wid * 16640);
                constexpr int I_UP = (DM / 64) * (NUP / 64);
                for (int it = (vb - f0) * 8 + wid; it < I_UP; it += nf * 8) p0_transpose_item<true, true>(a.in[16], DM, NUP, WupT, scr, it, lane, a.in[15]);
                asm volatile("s_waitcnt vmcnt(0)" ::: "memory");
                __syncthreads();
                if (tid == 0) __hip_atomic_fetch_add(WUPCNT, 1u, __ATOMIC_RELAXED, __HIP_MEMORY_SCOPE_AGENT);
            }
        }
    }
    SEAML(1, 2);
    if (IN(2)) REP(2) {
#ifndef NO_ATTN
        { const int u = (vb & 7) * 32 + (vb >> 3); attn_unit(lds, PROJ, MERGED, a.in[3], a.in[11], u, tid, wid, lane); }
#endif
#ifndef NO_LRU
        { const int u = (vb & 7) * 32 + (vb >> 3); lru_unit(lds, PROJ, WaT, WxT, a.in[4], a.in[5], a.in[7], a.in[9], SP, SUMM, FLAGS, a.in[12], MERGED, xlocal, u, tid, wid, lane); }
#endif
    }
    SEAML(2, 4);
    if (IN(4)) REP(4) {
        pg8::Gemm g{MERGED, WoutT, M, DM, DM}; pg8::StaticOrder S; S.init(M, DM, G, vb);
        pg8::PanelRms st1{XB0, CNT0}, st2{XB1, CNT1};
        pg8::EpiRmsResRms E{HN, X1B, (float*)XB1, a.in[14], st1, st2};
        pg8::gemm_phase<pg8::EpiRmsResRms, pg8::StaticOrder, false, true>(lds, g, S, E);
    }
    SEAML(4, 6);
    if (IN(6)) REP(6) {
        {
            constexpr int NU1 = (M / 256) * (INW / 256);
            const unsigned want = (unsigned)(((G < NU1) && (2 * G > NU1)) ? (2 * G - NU1) : G);
            if (tid == 0) { unsigned sp = 0; while (__hip_atomic_load(WUPCNT, __ATOMIC_RELAXED, __HIP_MEMORY_SCOPE_AGENT) < want) { __builtin_amdgcn_s_sleep(2); if (++sp > (1u << 22)) break; } }
            __syncthreads();
        }
        pg8::Gemm g{X1B, WupT, M, NUP, DM}; pg8::HalfTailOrder S; S.init(M, NUP, G, vb);
        pg8::EpiConvGate E{GB, EDGE, a.in[17], a.in[18], (const float*)XB1};
        pg8::gemm_phase<pg8::EpiConvGate, pg8::HalfTailOrder, true, true>(lds, g, S, E);
    }
    SEAML(6, 8);
    if (IN(8)) REP(8) {
        pg8::Gemm g{GB, WdnT, M, DM, DFF}; pg8::StaticOrder S; S.init(M, DM, G, vb);
        {
            const float* cw = a.in[17]; const float* cb = a.in[18];
            pg8::Unit uu;
            if (S.next(0, uu)) {
                const int B = 4 * uu.pm + uu.pn;
                const bool zero = (B % 32) == 0; const int Bp = zero ? B : B - 1;
#pragma unroll 3
                for (int idx = tid; idx < 2 * (DFF / 4); idx += 512) {
                    const int rsel = idx >= (DFF / 4) ? 1 : 0, ch = 4 * (idx - rsel * (DFF / 4));
                    f32x4 cv[2];
#pragma unroll
                    for (int gv = 0; gv < 2; ++gv) {
                        const int col = gv * DFF + ch;
                        const u32x2 r2 = *(const u32x2*)(EDGE + ((size_t)(Bp * 4 + 2) * 2 + gv) * DFF + ch), r1 = *(const u32x2*)(EDGE + ((size_t)(Bp * 4 + 3) * 2 + gv) * DFF + ch);
                        const u32x2 q0 = *(const u32x2*)(EDGE + ((size_t)(B * 4 + 0) * 2 + gv) * DFF + ch), q1 = *(const u32x2*)(EDGE + ((size_t)(B * 4 + 1) * 2 + gv) * DFF + ch);
                        f32x4 fm2 = (f32x4){bf_lo(r2.x), bf_hi(r2.x), bf_lo(r2.y), bf_hi(r2.y)}, fm1 = (f32x4){bf_lo(r1.x), bf_hi(r1.x), bf_lo(r1.y), bf_hi(r1.y)};
                        if (zero) { fm2 = (f32x4){0.f, 0.f, 0.f, 0.f}; fm1 = fm2; }
                        const f32x4 f0 = (f32x4){bf_lo(q0.x), bf_hi(q0.x), bf_lo(q0.y), bf_hi(q0.y)}, f1 = (f32x4){bf_lo(q1.x), bf_hi(q1.x), bf_lo(q1.y), bf_hi(q1.y)};
                        const f32x4 w0 = *(const f32x4*)(cw + col), w1 = *(const f32x4*)(cw + NUP + col), w2 = *(const f32x4*)(cw + 2 * NUP + col), bb = *(const f32x4*)(cb + col);
                        cv[gv] = rsel == 0 ? (w0 * fm2 + w1 * fm1 + w2 * f0 + bb) : (w0 * fm1 + w1 * f0 + w2 * f1 + bb);
                    }
                    const f32x4 go = gelu_tanh4(cv[0]) * cv[1];
                    u32x2 w; w.x = cvt_pk_bf16(go.x, go.y); w.y = cvt_pk_bf16(go.z, go.w);
                    *(u32x2*)(GB + (size_t)(64 * B + rsel) * DFF + ch) = w;
                }
                asm volatile("s_waitcnt vmcnt(0)" ::: "memory");
                __syncthreads();
                if (tid == 0) {
                    if (!xlocal) { __builtin_amdgcn_fence(__ATOMIC_RELEASE, "agent"); asm volatile("s_waitcnt vmcnt(0)" ::: "memory"); }
                    __hip_atomic_fetch_add(CNT3 + 64 * uu.pm, 1u, __ATOMIC_RELAXED, __HIP_MEMORY_SCOPE_AGENT);
                    unsigned sp = 0;
                    while (__hip_atomic_load(CNT3 + 64 * uu.pm, __ATOMIC_RELAXED, __HIP_MEMORY_SCOPE_AGENT) < 4u) { __builtin_amdgcn_s_sleep(2); if (++sp > (1u << 22)) break; }
                    __builtin_amdgcn_fence(__ATOMIC_ACQUIRE, "agent");
                    asm volatile("s_waitcnt vmcnt(0)" ::: "memory");
                }
                __syncthreads();
            }
        }
        pg8::PanelRms st{XB2, CNT2};
        pg8::EpiRmsRes E{X1B, out, a.in[20], st};
        pg8::gemm_phase<pg8::EpiRmsRes, pg8::StaticOrder, false, true>(lds, g, S, E);
    }
#undef IN
#undef SEAM
}

extern "C" void kernel_launch(void* const* d_in, const int* in_sizes, int n_in, void* d_out, int out_size, void* d_ws, size_t ws_size, hipStream_t stream) {
    static int grid = 0;
    if (grid == 0) {
        if (n_in != 21 || out_size != M * DM || ws_size < WS_END) { fprintf(stderr, "kernel_launch: unexpected problem shape (n_in %d out %d ws %zu)\n", n_in, out_size, ws_size); grid = -1; return; }
        int dev = 0, cus = 0, per_cu = 0;
        hipGetDevice(&dev); hipDeviceGetAttribute(&cus, hipDeviceAttributeMultiprocessorCount, dev);
        if (hipFuncSetAttribute((const void*)mk_fwd, hipFuncAttributeMaxDynamicSharedMemorySize, LDS_BYTES) != hipSuccess) { fprintf(stderr, "kernel_launch: hipFuncSetAttribute failed\n"); grid = -1; return; }
        if (hipOccupancyMaxActiveBlocksPerMultiprocessor(&per_cu, (const void*)mk_fwd, 512, LDS_BYTES) != hipSuccess || per_cu < 1) { fprintf(stderr, "kernel_launch: occupancy query says %d\n", per_cu); per_cu = 1; }
        (void)hipGetLastError();
        grid = cus * 1;
        if (grid > 256) grid = 256;
    }
    if (grid < 0) return;
    Args a{};
    for (int i = 0; i < 21; ++i) a.in[i] = (const float*)d_in[i];
    a.out = (float*)d_out; a.ws = (unsigned char*)d_ws;
#if MK_N_LAUNCHES == 1
    if (hipMemsetAsync(d_ws, 0, 16384 + 4 * 64 * 64 * 4 + 256 * 16 * 4, stream) != hipSuccess) { fprintf(stderr, "kernel_launch: memset failed\n"); return; }
    a.ph_lo = 0; a.ph_hi = N_PHASES;
    void* args[] = {&a};
    hipError_t e = hipLaunchCooperativeKernel((const void*)mk_fwd, dim3(grid), dim3(512), args, LDS_BYTES, stream);
    if (e != hipSuccess) fprintf(stderr, "cooperative launch failed: %s (grid %d)\n", hipGetErrorString(e), grid);
#else
    for (int p = 0; p < N_PHASES; ++p) { a.ph_lo = p; a.ph_hi = p + 1; hipLaunchKernelGGL(mk_fwd, dim3(grid), dim3(512), LDS_BYTES, stream, a); }
#endif
}
```

```cpp
#include <hip/hip_runtime.h>
#include <hip/hip_cooperative_groups.h>
#include <cstdio>
#include <cstdint>
namespace cg = cooperative_groups;

#ifndef MK_N_LAUNCHES
#define MK_N_LAUNCHES 1
#endif

#define LAS __attribute__((address_space(3)))
typedef unsigned short bf16_t;
typedef short bf16x8 __attribute__((ext_vector_type(8)));
typedef float f32x4 __attribute__((ext_vector_type(4)));
typedef float f32x2 __attribute__((ext_vector_type(2)));
typedef unsigned u32x4 __attribute__((ext_vector_type(4)));
typedef unsigned u32x2 __attribute__((ext_vector_type(2)));

constexpr int BATCH = 8, SEQ = 2048, DM = 1024, M = BATCH * SEQ;
constexpr int INW = 1792, DFF = 2816, NUP = 2 * DFF;
constexpr int KOFF = 512, VOFF = 640, LXOFF = 768, LGOFF = 1280;
constexpr float RMS_EPS = 1e-6f;
constexpr float LOG2E = 1.4426950408889634f;

constexpr size_t MiB = 1u << 20;
constexpr size_t WS_WIN = 1 * MiB;
constexpr size_t WS_WOUT = 5 * MiB;
constexpr size_t WS_WUP = 7 * MiB;
constexpr size_t WS_WDN = 18 * MiB;
constexpr size_t WS_WAT = 23 * MiB + 512 * 1024;
constexpr size_t WS_SUMM = 24 * MiB;
constexpr size_t WS_HN = 26 * MiB;
constexpr size_t WS_R1 = 58 * MiB;
constexpr size_t WS_MERGED = 122 * MiB;
constexpr size_t WS_HL = 154 * MiB;
constexpr size_t WS_ACUM = 170 * MiB;
constexpr size_t WS_G = 154 * MiB;
constexpr size_t WS_EDGE = 242 * MiB;
constexpr size_t WS_XB = 25 * MiB;
constexpr size_t WS_END = 254 * MiB;

constexpr int LDS_BYTES = 163840;

__device__ __forceinline__ unsigned cvt_pk_bf16(float lo, float hi) { unsigned r; asm volatile("v_cvt_pk_bf16_f32 %0, %1, %2" : "=v"(r) : "v"(lo), "v"(hi)); return r; }
__device__ __forceinline__ float bf_lo(unsigned w) { return __uint_as_float(w << 16); }
__device__ __forceinline__ float bf_hi(unsigned w) { return __uint_as_float(w & 0xffff0000u); }
__device__ __forceinline__ float fast_exp2(float x) { return __builtin_amdgcn_exp2f(x); }
__device__ __forceinline__ float fast_rcp(float x) { return __builtin_amdgcn_rcpf(x); }
__device__ __forceinline__ float sigmoidf_(float z) { return fast_rcp(1.0f + fast_exp2(-LOG2E * z)); }
__device__ __forceinline__ float gelu_tanh(float x) {
    const float u = x * (1.0f + 0.044715f * x * x);
    return x * fast_rcp(1.0f + fast_exp2(-2.0f * 0.7978845608028654f * LOG2E * u));
}
__device__ __forceinline__ f32x4 gelu_tanh4(f32x4 x) {
    const f32x4 u = x * (x * x * 0.044715f + 1.0f);
    const f32x4 t = u * (-2.0f * 0.7978845608028654f * LOG2E);
    f32x4 e; e.x = fast_exp2(t.x); e.y = fast_exp2(t.y); e.z = fast_exp2(t.z); e.w = fast_exp2(t.w);
    const f32x4 d = e + 1.0f;
    f32x4 r; r.x = fast_rcp(d.x); r.y = fast_rcp(d.y); r.z = fast_rcp(d.z); r.w = fast_rcp(d.w);
    return x * r;
}
template <int CTRL> __device__ __forceinline__ float dpp_keep(float oldv, float v) {
    return __int_as_float(__builtin_amdgcn_update_dpp(__float_as_int(oldv), __float_as_int(v), CTRL, 0xf, 0xf, false));
}
template <int CTRL> __device__ __forceinline__ float dpp_zf(float v) {
    return __int_as_float(__builtin_amdgcn_update_dpp(0, __float_as_int(v), CTRL, 0xf, 0xf, true));
}
template <int CTRL> __device__ __forceinline__ float dpp_rot(float v) {
    return __int_as_float(__builtin_amdgcn_mov_dpp(__float_as_int(v), CTRL, 0xf, 0xf, true));
}
__device__ __forceinline__ float wave_sum(float v) {
#pragma unroll
    for (int o = 1; o < 64; o <<= 1) v += __shfl_xor(v, o);
    return v;
}

namespace pg8 {
constexpr int BM = 256, BK = 64, HALF = 128, HTB = HALF * BK * 2, STAGE_BYTES = 8 * HTB, NXCD = 8, WGM = 8;
__host__ __device__ __forceinline__ int lds_byte(int r, int c) { const int st = (r >> 4) * 2 + (c >> 5), rr = r & 15, cc = c & 31, ob = rr * 64 + cc * 2; return st * 1024 + (ob ^ (((ob >> 9) & 1) << 5)); }
__host__ __device__ __forceinline__ void stage_rc(int b, int& R, int& C) { const int st = b / 1024, sb = b % 1024, swz = sb ^ (((sb >> 9) & 1) << 5); R = (st >> 1) * 16 + swz / 64; C = (st & 1) * 32 + (swz % 64) / 2; }
__host__ __device__ __forceinline__ int perm32(int rho) { const int n = rho >> 4, i = rho & 15; return 8 * (i >> 2) + 4 * n + (i & 3); }
struct Unit { int pm, pn, half; };
struct Gemm { const bf16_t* A; const bf16_t* Bt; int M, N, K; };
struct StaticOrder {
    int nM, nN, nwg, G, c;
    __host__ __device__ void init(int M_, int N_, int G_, int c_) { nM = M_ / BM; nN = N_ / BM; nwg = nM * nN; G = G_; c = c_; }
    __host__ __device__ bool next(int i, Unit& u) const {
        const long L = (long)i * G + c; if (L >= nwg) return false;
        int wgid = (int)L; { const int q = nwg / NXCD, r = nwg % NXCD, xcd = wgid % NXCD, off = wgid / NXCD; wgid = (xcd < r ? xcd * (q + 1) : r * (q + 1) + (xcd - r) * q) + off; }
        const int nig = WGM * nN, gid = wgid / nig, fm = gid * WGM, gsz = (nM - fm) < WGM ? (nM - fm) : WGM;
        u.pm = fm + ((wgid % nig) % gsz); u.pn = (wgid % nig) / gsz; u.half = 0; return true;
    }
};
struct HalfTailOrder {
    StaticOrder so; int nfull, rem;
    __host__ __device__ void init(int M_, int N_, int G_, int c_) { so.init(M_, N_, G_, c_); nfull = so.nwg / G_; rem = so.nwg - nfull * G_; }
    __host__ __device__ bool next(int i, Unit& u) const {
        if (rem == 0 || 2 * rem > so.G || (rem % 8) != 0 || (so.G % 8) != 0) return so.next(i, u);
        if (i < nfull) return so.next(i, u);
        if (i > nfull || (so.c >> 3) >= 2 * (rem / 8)) return false;
        StaticOrder t = so; t.c = ((so.c >> 3) >> 1) * 8 + (so.c & 7);
        if (!t.next(nfull, u)) return false;
        u.half = 1 + ((so.c >> 3) & 1); return true;
    }
};
struct EpiBf16 {
    static constexpr bool CONV = false;
    static constexpr bool PERM = true;
    static constexpr bool AFTER_DRAIN = false;
    bf16_t* O; int ldc; const float* rowscale;
    __device__ __forceinline__ void operator()(const f32x4 (&acc)[2][2][4][2], const Unit& u, int wr, int wc, int fr, int fq) const {
        const int row0 = u.pm * BM + wr * 64 + fr, col0 = u.pn * BM + wc * 32 + 8 * fq;
        float rsv[2][4];
#pragma unroll
        for (int ai = 0; ai < 2; ++ai)
#pragma unroll
            for (int m = 0; m < 4; ++m) rsv[ai][m] = rowscale[row0 + ai * HALF + m * 16];
#pragma unroll
        for (int ai = 0; ai < 2; ++ai)
#pragma unroll
            for (int m = 0; m < 4; ++m) { const int row = row0 + ai * HALF + m * 16; const float rsc = rsv[ai][m]; bf16_t* rowp = O + (size_t)row * ldc + col0;
#pragma unroll
                for (int bj = 0; bj < 2; ++bj) { const f32x4 v0 = acc[ai][bj][m][0] * rsc, v1 = acc[ai][bj][m][1] * rsc;
                    u32x4 w; w.x = cvt_pk_bf16(v0[0], v0[1]); w.y = cvt_pk_bf16(v0[2], v0[3]); w.z = cvt_pk_bf16(v1[0], v1[1]); w.w = cvt_pk_bf16(v1[2], v1[3]); *(u32x4*)(rowp + bj * HALF) = w; } }
    }
};
struct EpiF32 {
    static constexpr bool CONV = false;
    static constexpr bool PERM = false;
    static constexpr bool AFTER_DRAIN = false;
    float* O; int ldc;
    __device__ __forceinline__ void operator()(const f32x4 (&acc)[2][2][4][2], const Unit& u, int wr, int wc, int fr, int fq) const {
        const int row0 = u.pm * BM + wr * 64 + fr, col0 = u.pn * BM + wc * 32 + 4 * fq;
#pragma unroll
        for (int ai = 0; ai < 2; ++ai)
#pragma unroll
            for (int m = 0; m < 4; ++m) { float* rowp = O + (size_t)(row0 + ai * HALF + m * 16) * ldc + col0;
#pragma unroll
                for (int bj = 0; bj < 2; ++bj)
#pragma unroll
                    for (int n = 0; n < 2; ++n) *(f32x4*)(rowp + bj * HALF + n * 16) = acc[ai][bj][m][n]; }
    }
};
struct EpiConvGate {
    static constexpr bool CONV = true;
    static constexpr bool PERM = true;
    static constexpr bool AFTER_DRAIN = false;
    bf16_t* G; bf16_t* E; const float* cw; const float* cb; const float* rowscale;
    static constexpr int CBUF_OFF = 131072, CBUF_BYTES = 8192;
    __device__ __forceinline__ void prefetch(LAS unsigned char* lds, const Unit& u, int buf, int tid, int wid) const {
        const int rowbase = u.pm * BM + (u.half == 2 ? HALF : 0);
#pragma unroll
        for (int it = 0; it < 4; ++it) {
            const int f = it * 512 + tid;
            const float* gp;
            if (f < 1024) { const int sgm = f >> 7, c = f & 127; const float* sb = (sgm & 3) == 3 ? cb : cw + (sgm & 3) * NUP; gp = sb + (sgm >> 2) * DFF + u.pn * 128 + c; }
            else gp = rowscale + (size_t)rowbase * 4 + (f - 1024);
            __builtin_amdgcn_global_load_lds((const unsigned*)gp, (LAS unsigned*)(lds + CBUF_OFF + buf * CBUF_BYTES + (it * 512 + wid * 64) * 4), 4, 0, 0);
        }
    }
    __device__ __forceinline__ void operator()(const f32x4 (&acc)[2][2][4][2], const Unit& u, int wr, int wc, int fr, int fq, LAS unsigned char* lds, int buf) const {
        const LAS float* CB = (const LAS float*)(lds + CBUF_OFF + buf * CBUF_BYTES);
        u32x2 pk0[2][4];
        float rsv[2][4];
#pragma unroll
        for (int ai = 0; ai < 2; ++ai)
#pragma unroll
            for (int m = 0; m < 4; ++m) { const f32x4 p = *(const LAS f32x4*)(CB + 1024 + 4 * ((u.half ? 0 : ai * HALF) + wr * 64 + 16 * m + fr));
                rsv[ai][m] = __builtin_amdgcn_rsqf(((p.x + p.y) + (p.z + p.w)) * (1.0f / 1024.0f) + RMS_EPS); }
#pragma unroll
        for (int n = 0; n < 2; ++n) {
            const int ch = u.pn * 128 + wc * 32 + 8 * fq + 4 * n;
            const int cc = wc * 32 + 8 * fq + 4 * n;
            const f32x4 wg0 = *(const LAS f32x4*)(CB + cc), wg1 = *(const LAS f32x4*)(CB + 128 + cc), wg2 = *(const LAS f32x4*)(CB + 256 + cc), bg = *(const LAS f32x4*)(CB + 384 + cc);
            const f32x4 wv0 = *(const LAS f32x4*)(CB + 512 + cc), wv1 = *(const LAS f32x4*)(CB + 640 + cc), wv2 = *(const LAS f32x4*)(CB + 768 + cc), bv = *(const LAS f32x4*)(CB + 896 + cc);
#pragma unroll
            for (int ai = 0; ai < 2; ++ai) {
                if (ai == 1 && u.half) continue;
                const int rb = u.pm * BM + (u.half == 2 ? HALF : 0) + ai * HALF + wr * 64, blk = rb >> 6;
                f32x4 pg = (f32x4){0.f, 0.f, 0.f, 0.f}, pv = pg;
#pragma unroll
                for (int m = 0; m < 4; ++m) {
                    const float rsc = rsv[ai][m];
                    const f32x4 g = acc[ai][0][m][n] * rsc, v = acc[ai][1][m][n] * rsc;
                    if (m == 0 && fr < 2) { bf16_t* e = E + ((size_t)(blk * 4 + fr) * 2) * DFF + ch; *(u32x2*)e = (u32x2){cvt_pk_bf16(g[0], g[1]), cvt_pk_bf16(g[2], g[3])}; *(u32x2*)(e + DFF) = (u32x2){cvt_pk_bf16(v[0], v[1]), cvt_pk_bf16(v[2], v[3])}; }
                    if (m == 3 && fr >= 14) { bf16_t* e = E + ((size_t)(blk * 4 + fr - 12) * 2) * DFF + ch; *(u32x2*)e = (u32x2){cvt_pk_bf16(g[0], g[1]), cvt_pk_bf16(g[2], g[3])}; *(u32x2*)(e + DFF) = (u32x2){cvt_pk_bf16(v[0], v[1]), cvt_pk_bf16(v[2], v[3])}; }
                    f32x4 sg1, sg2, sv1, sv2;
#pragma unroll
                    for (int j = 0; j < 4; ++j) { sg1[j] = fr == 15 ? pg[j] : g[j]; sg2[j] = fr >= 14 ? pg[j] : g[j]; sv1[j] = fr == 15 ? pv[j] : v[j]; sv2[j] = fr >= 14 ? pv[j] : v[j]; }
                    f32x4 g1, g2, v1, v2;
#pragma unroll
                    for (int j = 0; j < 4; ++j) { g1[j] = dpp_rot<0x121>(sg1[j]); g2[j] = dpp_rot<0x122>(sg2[j]); v1[j] = dpp_rot<0x121>(sv1[j]); v2[j] = dpp_rot<0x122>(sv2[j]); }
                    const f32x4 cgv = wg0 * g2 + wg1 * g1 + wg2 * g + bg;
                    const f32x4 cvv = wv0 * v2 + wv1 * v1 + wv2 * v + bv;
                    const f32x4 o = gelu_tanh4(cgv) * cvv;
                    u32x2 w; w.x = cvt_pk_bf16(o[0], o[1]); w.y = cvt_pk_bf16(o[2], o[3]);
                    if (n == 0) pk0[ai][m] = w;
                    else *(u32x4*)(G + (size_t)(rb + 16 * m + fr) * DFF + ch - 4) = (u32x4){pk0[ai][m].x, pk0[ai][m].y, w.x, w.y};
                    pg = g; pv = v;
                }
            }
        }
    }
};

struct PanelRms {
    unsigned* xbuf;
    unsigned* cnt;
    __device__ __forceinline__ void run(const f32x4 (&v)[2][2][4][2], const Unit& u, int wr, int wc, int fr, int fq, LAS unsigned char* lds, int wid, int lane) const {
        LAS float* P = (LAS float*)lds;
        LAS float* S = (LAS float*)(lds + 8192);
#pragma unroll
        for (int ai = 0; ai < 2; ++ai)
#pragma unroll
            for (int m = 0; m < 4; ++m) {
                float s = 0.f;
#pragma unroll
                for (int bj = 0; bj < 2; ++bj)
#pragma unroll
                    for (int n = 0; n < 2; ++n) { const f32x4 x = v[ai][bj][m][n]; s += (x[0] * x[0] + x[1] * x[1]) + (x[2] * x[2] + x[3] * x[3]); }
                s += __shfl_xor(s, 16); s += __shfl_xor(s, 32);
                if (fq == 0) P[(ai * HALF + wr * 64 + m * 16 + fr) * 4 + wc] = s;
            }
        asm volatile("s_waitcnt lgkmcnt(0)" ::: "memory"); __builtin_amdgcn_s_barrier(); asm volatile("" ::: "memory");
        const int row = wid * 32 + (lane & 31);
        if (lane < 32) {
            const f32x4 p = *(const LAS f32x4*)(P + row * 4);
            __hip_atomic_store(xbuf + (size_t)(u.pm * BM + row) * 4 + u.pn, __float_as_uint((p.x + p.y) + (p.z + p.w)), __ATOMIC_RELAXED, __HIP_MEMORY_SCOPE_AGENT);
        }
        asm volatile("s_waitcnt vmcnt(0)" ::: "memory");
        if (lane == 0) __hip_atomic_fetch_add(cnt + 64 * u.pm, 1u, __ATOMIC_RELAXED, __HIP_MEMORY_SCOPE_AGENT);
        if (wid == 0) {
            unsigned sp = 0;
            while ((unsigned)__builtin_amdgcn_readfirstlane(__hip_atomic_load(cnt + 64 * u.pm, __ATOMIC_RELAXED, __HIP_MEMORY_SCOPE_AGENT)) < 32u) { __builtin_amdgcn_s_sleep(2); if (++sp > (1u << 22)) break; }
        }
        asm volatile("s_waitcnt vmcnt(0) lgkmcnt(0)" ::: "memory"); __builtin_amdgcn_s_barrier(); asm volatile("" ::: "memory");
        if (lane < 32) {
            const unsigned* slot = xbuf + (size_t)(u.pm * BM + row) * 4; float tot = 0.f;
#pragma unroll
            for (int t = 0; t < 4; ++t) tot += __uint_as_float(__hip_atomic_load(slot + t, __ATOMIC_RELAXED, __HIP_MEMORY_SCOPE_AGENT));
            S[row] = 1.0f / sqrtf(tot * (1.0f / 1024.0f) + RMS_EPS);
        }
        asm volatile("s_waitcnt lgkmcnt(0)" ::: "memory"); __builtin_amdgcn_s_barrier(); asm volatile("" ::: "memory");
    }
};
__device__ __forceinline__ void publish_row_ssq(const f32x4 (&v)[2][2][4][2], const Unit& u, int wr, int wc, int fr, int fq, LAS unsigned char* lds, int wid, int lane, float* pbuf) {
    LAS float* P = (LAS float*)lds;
#pragma unroll
    for (int ai = 0; ai < 2; ++ai)
#pragma unroll
        for (int m = 0; m < 4; ++m) {
            float s = 0.f;
#pragma unroll
            for (int bj = 0; bj < 2; ++bj)
#pragma unroll
                for (int n = 0; n < 2; ++n) { const f32x4 x = v[ai][bj][m][n]; s += (x[0] * x[0] + x[1] * x[1]) + (x[2] * x[2] + x[3] * x[3]); }
            s += __shfl_xor(s, 16); s += __shfl_xor(s, 32);
            if (fq == 0) P[(ai * HALF + wr * 64 + m * 16 + fr) * 4 + wc] = s;
        }
    asm volatile("s_waitcnt lgkmcnt(0)" ::: "memory"); __builtin_amdgcn_s_barrier(); asm volatile("" ::: "memory");
    const int row = wid * 32 + (lane & 31);
    if (lane < 32) { const f32x4 p = *(const LAS f32x4*)(P + row * 4); pbuf[(size_t)(u.pm * BM + row) * 4 + u.pn] = (p.x + p.y) + (p.z + p.w); }
}
struct EpiRmsResRms {
    static constexpr bool CONV = false;
    static constexpr bool PERM = true;
    static constexpr bool AFTER_DRAIN = true;
    const bf16_t* xb; bf16_t* x1b; float* rs2; const float* g1; PanelRms st1, st2;
    __device__ __forceinline__ void fused(f32x4 (&acc)[2][2][4][2], const Unit& u, int wr, int wc, int fr, int fq, LAS unsigned char* lds, int wid, int lane) const {
        const LAS float* S = (const LAS float*)(lds + 8192);
        const int col0 = u.pn * BM + wc * 32 + 8 * fq;
        u32x4 pre[2][4][2];
#pragma unroll
        for (int ai = 0; ai < 2; ++ai)
#pragma unroll
            for (int m = 0; m < 4; ++m) { const size_t off = (size_t)(u.pm * BM + ai * HALF + wr * 64 + m * 16 + fr) * DM + col0;
#pragma unroll
                for (int bj = 0; bj < 2; ++bj) pre[ai][m][bj] = *(const u32x4*)(xb + off + bj * HALF); }
        st1.run(acc, u, wr, wc, fr, fq, lds, wid, lane);
        f32x4 gv[2][2];
#pragma unroll
        for (int bj = 0; bj < 2; ++bj)
#pragma unroll
            for (int n = 0; n < 2; ++n) gv[bj][n] = *(const f32x4*)(g1 + col0 + bj * HALF + 4 * n);
#pragma unroll
        for (int ai = 0; ai < 2; ++ai)
#pragma unroll
            for (int m = 0; m < 4; ++m) { const int r = ai * HALF + wr * 64 + m * 16 + fr; const float rs = S[r]; const size_t off = (size_t)(u.pm * BM + r) * DM + col0;
#pragma unroll
                for (int bj = 0; bj < 2; ++bj) { const u32x4 p = pre[ai][m][bj];
                    const f32x4 x0 = (f32x4){bf_lo(p.x), bf_hi(p.x), bf_lo(p.y), bf_hi(p.y)} + acc[ai][bj][m][0] * rs * gv[bj][0];
                    const f32x4 x1 = (f32x4){bf_lo(p.z), bf_hi(p.z), bf_lo(p.w), bf_hi(p.w)} + acc[ai][bj][m][1] * rs * gv[bj][1];
                    acc[ai][bj][m][0] = x0; acc[ai][bj][m][1] = x1;
                    u32x4 w; w.x = cvt_pk_bf16(x0[0], x0[1]); w.y = cvt_pk_bf16(x0[2], x0[3]); w.z = cvt_pk_bf16(x1[0], x1[1]); w.w = cvt_pk_bf16(x1[2], x1[3]);
                    *(u32x4*)(x1b + off + bj * HALF) = w; }
                if (m & 1) asm volatile("" ::: "memory"); }
        publish_row_ssq(acc, u, wr, wc, fr, fq, lds, wid, lane, rs2);
    }
};
struct EpiRmsRes {
    static constexpr bool CONV = false;
    static constexpr bool PERM = true;
    static constexpr bool AFTER_DRAIN = true;
    const bf16_t* x1b; float* out; const float* g; PanelRms st;
    __device__ __forceinline__ void fused(f32x4 (&acc)[2][2][4][2], const Unit& u, int wr, int wc, int fr, int fq, LAS unsigned char* lds, int wid, int lane) const {
        const LAS float* S = (const LAS float*)(lds + 8192);
        const int col0 = u.pn * BM + wc * 32 + 8 * fq;
        u32x4 pre[2][4][2];
#pragma unroll
        for (int ai = 0; ai < 2; ++ai)
#pragma unroll
            for (int m = 0; m < 4; ++m) { const size_t off = (size_t)(u.pm * BM + ai * HALF + wr * 64 + m * 16 + fr) * DM + col0;
#pragma unroll
                for (int bj = 0; bj < 2; ++bj) pre[ai][m][bj] = *(const u32x4*)(x1b + off + bj * HALF); }
        st.run(acc, u, wr, wc, fr, fq, lds, wid, lane);
        f32x4 gv[2][2];
#pragma unroll
        for (int bj = 0; bj < 2; ++bj)
#pragma unroll
            for (int n = 0; n < 2; ++n) gv[bj][n] = *(const f32x4*)(g + col0 + bj * HALF + 4 * n);
#pragma unroll
        for (int ai = 0; ai < 2; ++ai)
#pragma unroll
            for (int m = 0; m < 4; ++m) { const int r = ai * HALF + wr * 64 + m * 16 + fr; const float rs = S[r]; const size_t off = (size_t)(u.pm * BM + r) * DM + col0;
#pragma unroll
                for (int bj = 0; bj < 2; ++bj) { const u32x4 p = pre[ai][m][bj];
                    *(f32x4*)(out + off + bj * HALF) = (f32x4){bf_lo(p.x), bf_hi(p.x), bf_lo(p.y), bf_hi(p.y)} + acc[ai][bj][m][0] * rs * gv[bj][0];
                    *(f32x4*)(out + off + bj * HALF + 4) = (f32x4){bf_lo(p.z), bf_hi(p.z), bf_lo(p.w), bf_hi(p.w)} + acc[ai][bj][m][1] * rs * gv[bj][1]; }
                if (m & 1) asm volatile("" ::: "memory"); }
    }
};

template <class Epi, class Sched, bool ALIGN_EPI, bool SP2>
__device__ __forceinline__ void gemm_phase(LAS unsigned char* lds, const Gemm g, const Sched& S, const Epi& E) {
    const int tid = threadIdx.x, wid = __builtin_amdgcn_readfirstlane(tid >> 6), lane = tid & 63, wr = wid >> 2, wc = wid & 3, fr = lane & 15, fq = lane >> 4;
    const int K = g.K, nt = K / BK;
    unsigned voffA[2], voffB[2];
#pragma unroll
    for (int i = 0; i < 2; ++i) { int R, C; stage_rc(tid * 16 + i * 8192, R, C); const int Rb = Epi::PERM ? ((R & ~31) + perm32(R & 31)) : R; voffA[i] = (unsigned)(R * K + C) * 2u; voffB[i] = (unsigned)(Rb * K + C) * 2u; }
    const size_t kstep = (size_t)(BK * 2);
    const size_t hstep = (size_t)HALF * K * 2;
    const size_t tstep = 2 * hstep;
    const unsigned ldsw = (unsigned)wid * 1024u;
    const int aoff = lds_byte(wr * 64 + fr, fq * 8), boff = lds_byte(wc * 32 + fr, fq * 8);
#define PG8_SA(b, h) (((b) * 2 + (h)) * HTB)
#define PG8_SB(b, h) ((4 + (b) * 2 + (h)) * HTB)
#define PG8_STAGE(bufoff, gbase, voff) do { _Pragma("unroll") for (int _i = 0; _i < 2; ++_i) \
        __builtin_amdgcn_global_load_lds((const unsigned*)((const char*)(gbase) + (voff)[_i]), (LAS unsigned*)(lds + (bufoff) + ldsw + _i * 8192), 16, 0, 0); } while (0)
#define PG8_LDA(dst, b, h) do { _Pragma("unroll") for (int m = 0; m < 4; ++m) _Pragma("unroll") for (int k = 0; k < 2; ++k) dst[m][k] = *(const LAS bf16x8*)(lds + PG8_SA(b, h) + aoff + m * 2048 + k * 1024); } while (0)
#define PG8_LDB(dst, b, h) do { _Pragma("unroll") for (int n = 0; n < 2; ++n) _Pragma("unroll") for (int k = 0; k < 2; ++k) dst[n][k] = *(const LAS bf16x8*)(lds + PG8_SB(b, h) + boff + n * 2048 + k * 1024); } while (0)
#define PG8_MMA(ai, bj, At, Bt) do { __builtin_amdgcn_s_setprio(1); _Pragma("unroll") for (int m = 0; m < 4; ++m) _Pragma("unroll") for (int n = 0; n < 2; ++n) _Pragma("unroll") for (int k = 0; k < 2; ++k) \
        acc[ai][bj][m][n] = __builtin_amdgcn_mfma_f32_16x16x32_bf16(Bt[n][k], At[m][k], acc[ai][bj][m][n], 0, 0, 0); __builtin_amdgcn_s_setprio(0); } while (0)
#define PG8_WAIT_V(n) asm volatile("s_waitcnt vmcnt(" #n ")" ::: "memory")
#define PG8_WAIT_L(n) asm volatile("s_waitcnt lgkmcnt(" #n ")" ::: "memory")
#define PG8_BAR __builtin_amdgcn_s_barrier()
#define PG8_SCHED __builtin_amdgcn_sched_barrier(0)
    Unit cur, nxt; int ui = 0;
    if (!S.next(0, cur)) return;
    f32x4 acc[2][2][4][2];
#pragma unroll
    for (int a = 0; a < 2; ++a)
#pragma unroll
        for (int b = 0; b < 2; ++b)
#pragma unroll
            for (int m = 0; m < 4; ++m)
#pragma unroll
                for (int n = 0; n < 2; ++n) acc[a][b][m][n] = (f32x4){0.f, 0.f, 0.f, 0.f};
    bf16x8 At[4][2], B0[2][2], B1[2][2];
    const char* cA = (const char*)g.A + (size_t)cur.pm * tstep + (cur.half == 2 ? hstep : 0); const char* cB = (const char*)g.Bt + (size_t)cur.pn * tstep;
    if constexpr (Epi::CONV) E.prefetch(lds, cur, 0, tid, wid);
    if constexpr (SP2) {
        PG8_STAGE(PG8_SB(0, 0), cB, voffB); PG8_STAGE(PG8_SB(0, 1), cB + hstep, voffB); PG8_STAGE(PG8_SA(0, 0), cA, voffA); PG8_STAGE(PG8_SA(0, 1), cA + hstep, voffA);
        if (wr == 1) PG8_BAR;
        PG8_WAIT_V(2); PG8_BAR;
        PG8_STAGE(PG8_SB(1, 0), cB + kstep, voffB); PG8_STAGE(PG8_SA(1, 0), cA + kstep, voffA); PG8_STAGE(PG8_SB(1, 1), cB + hstep + kstep, voffB);
        PG8_WAIT_V(6); PG8_BAR;
    } else {
        PG8_STAGE(PG8_SB(0, 0), cB, voffB); PG8_STAGE(PG8_SA(0, 0), cA, voffA); PG8_STAGE(PG8_SB(0, 1), cB + hstep, voffB); PG8_STAGE(PG8_SA(0, 1), cA + hstep, voffA);
        if (wr == 1) PG8_BAR;
        PG8_WAIT_V(4); PG8_BAR;
        PG8_STAGE(PG8_SB(1, 0), cB + kstep, voffB); PG8_STAGE(PG8_SA(1, 0), cA + kstep, voffA); PG8_STAGE(PG8_SB(1, 1), cB + hstep + kstep, voffB);
        PG8_WAIT_V(6); PG8_BAR;
    }
    for (;;) {
        const bool has_next = S.next(ui + 1, nxt);
        const char* nA = has_next ? (const char*)g.A + (size_t)nxt.pm * tstep + (nxt.half == 2 ? hstep : 0) : cA; const char* nB = has_next ? (const char*)g.Bt + (size_t)nxt.pn * tstep : cB;
        for (int t = 0; t < nt; t += 2) {
            const bool last = (t == nt - 2);
            const char* a1 = cA + (size_t)(t + 1) * kstep;
            const char* a2 = last ? nA : cA + (size_t)(t + 2) * kstep; const char* b2 = last ? nB : cB + (size_t)(t + 2) * kstep;
            const char* a3 = a2 + kstep; const char* b3 = b2 + kstep;
            if constexpr (Epi::CONV) { if (last && has_next) E.prefetch(lds, nxt, (ui + 1) & 1, tid, wid); }
            if constexpr (SP2) {
            PG8_LDB(B0, 0, 0); PG8_LDB(B1, 0, 1); PG8_SCHED; PG8_LDA(At, 0, 0); PG8_STAGE(PG8_SA(1, 1), a1 + hstep, voffA);
            PG8_WAIT_V(8); PG8_WAIT_L(0); PG8_BAR; PG8_MMA(0, 0, At, B0); PG8_MMA(0, 1, At, B1); PG8_BAR; PG8_SCHED;
            if (!cur.half) PG8_LDA(At, 0, 1); PG8_STAGE(PG8_SB(0, 0), b2, voffB); PG8_STAGE(PG8_SB(0, 1), b2 + hstep, voffB); PG8_STAGE(PG8_SA(0, 0), a2, voffA);
            PG8_WAIT_V(8); PG8_WAIT_L(0); PG8_BAR; if (!cur.half) { PG8_MMA(1, 0, At, B0); PG8_MMA(1, 1, At, B1); } PG8_BAR; PG8_SCHED;
            PG8_LDB(B0, 1, 0); PG8_LDB(B1, 1, 1); PG8_SCHED; PG8_LDA(At, 1, 0); PG8_STAGE(PG8_SA(0, 1), a2 + hstep, voffA);
            PG8_WAIT_V(8); PG8_WAIT_L(0); PG8_BAR; PG8_MMA(0, 0, At, B0); PG8_MMA(0, 1, At, B1); PG8_BAR; PG8_SCHED;
            if (!cur.half) PG8_LDA(At, 1, 1); PG8_STAGE(PG8_SB(1, 0), b3, voffB); PG8_STAGE(PG8_SB(1, 1), b3 + hstep, voffB); PG8_STAGE(PG8_SA(1, 0), a3, voffA);
            PG8_WAIT_V(8); PG8_WAIT_L(0); PG8_BAR; if (!cur.half) { PG8_MMA(1, 0, At, B0); PG8_MMA(1, 1, At, B1); } PG8_BAR; PG8_SCHED;
            } else {
            PG8_LDB(B0, 0, 0); PG8_SCHED; PG8_LDA(At, 0, 0); PG8_STAGE(PG8_SA(1, 1), a1 + hstep, voffA);
            PG8_WAIT_L(8); PG8_BAR; PG8_WAIT_L(0); PG8_MMA(0, 0, At, B0); PG8_BAR; PG8_SCHED;
            PG8_LDB(B1, 0, 1); PG8_STAGE(PG8_SB(0, 0), b2, voffB);
            PG8_BAR; PG8_WAIT_L(0); PG8_MMA(0, 1, At, B1); PG8_BAR;
            PG8_LDA(At, 0, 1); PG8_STAGE(PG8_SA(0, 0), a2, voffA);
            PG8_BAR; PG8_WAIT_L(0); PG8_MMA(1, 0, At, B0); PG8_BAR; PG8_SCHED;
            PG8_STAGE(PG8_SB(0, 1), b2 + hstep, voffB);
            PG8_WAIT_V(6); PG8_BAR; PG8_MMA(1, 1, At, B1); PG8_BAR;
            PG8_LDB(B0, 1, 0); PG8_SCHED; PG8_LDA(At, 1, 0); PG8_STAGE(PG8_SA(0, 1), a2 + hstep, voffA);
            PG8_WAIT_L(8); PG8_BAR; PG8_WAIT_L(0); PG8_MMA(0, 0, At, B0); PG8_BAR; PG8_SCHED;
            PG8_LDB(B1, 1, 1); PG8_STAGE(PG8_SB(1, 0), b3, voffB);
            PG8_BAR; PG8_WAIT_L(0); PG8_MMA(0, 1, At, B1); PG8_BAR;
            PG8_LDA(At, 1, 1); PG8_STAGE(PG8_SA(1, 0), a3, voffA);
            PG8_BAR; PG8_WAIT_L(0); PG8_MMA(1, 0, At, B0); PG8_BAR; PG8_SCHED;
            PG8_STAGE(PG8_SB(1, 1), b3 + hstep, voffB);
            PG8_WAIT_V(6); PG8_BAR; PG8_MMA(1, 1, At, B1); PG8_BAR;
            }
        }
        if constexpr (ALIGN_EPI) { if (wr == 0) PG8_BAR; }
        if constexpr (Epi::CONV) E(acc, cur, wr, wc, fr, fq, lds, ui & 1);
        else if constexpr (!Epi::AFTER_DRAIN) E(acc, cur, wr, wc, fr, fq);
        if (!has_next) break;
#pragma unroll
        for (int a = 0; a < 2; ++a)
#pragma unroll
            for (int b = 0; b < 2; ++b)
#pragma unroll
                for (int m = 0; m < 4; ++m)
#pragma unroll
                    for (int n = 0; n < 2; ++n) acc[a][b][m][n] = (f32x4){0.f, 0.f, 0.f, 0.f};
        cur = nxt; cA = nA; cB = nB; ++ui;
        if constexpr (ALIGN_EPI) { if (wr == 1) PG8_BAR; }
    }
    PG8_WAIT_V(0);
    if constexpr (!ALIGN_EPI) { if (wr == 0) PG8_BAR; }
    PG8_BAR;
    if constexpr (Epi::AFTER_DRAIN) E.fused(acc, cur, wr, wc, fr, fq, lds, wid, lane);
#undef PG8_SA
#undef PG8_SB
#undef PG8_STAGE
#undef PG8_LDA
#undef PG8_LDB
#undef PG8_MMA
#undef PG8_WAIT_V
#undef PG8_WAIT_L
#undef PG8_BAR
#undef PG8_SCHED
}
}

template <bool PERMUP, bool WTHRU = false>
__device__ __forceinline__ void p0_transpose_item(const float* W, int K, int N, bf16_t* WT, LAS float* scr, int item, int lane, const float* kgain = nullptr) {
    const int nblk = N / 64, kb = item / nblk, nb = item % nblk, k0 = 64 * kb, n0 = 64 * nb;
    int d0 = n0;
    if (PERMUP) d0 = (n0 < DFF) ? (256 * (n0 / 128) + (n0 % 128)) : (256 * ((n0 - DFF) / 128) + 128 + ((n0 - DFF) % 128));
#pragma unroll 16
    for (int i = 0; i < 64; ++i) scr[i * 65 + lane] = W[(size_t)(k0 + i) * N + n0 + lane];
    asm volatile("s_waitcnt lgkmcnt(0)" ::: "memory");
    const int c = lane & 7;
    f32x4 ga = (f32x4){1.f, 1.f, 1.f, 1.f}, gb = ga;
    if (kgain) { ga = *(const f32x4*)(kgain + k0 + 8 * c); gb = *(const f32x4*)(kgain + k0 + 8 * c + 4); }
#pragma unroll
    for (int j = 0; j < 8; ++j) { const int n = (lane >> 3) + 8 * j; const LAS float* s = scr + (8 * c) * 65 + n;
        u32x4 o; o.x = cvt_pk_bf16(s[0 * 65] * ga.x, s[1 * 65] * ga.y); o.y = cvt_pk_bf16(s[2 * 65] * ga.z, s[3 * 65] * ga.w); o.z = cvt_pk_bf16(s[4 * 65] * gb.x, s[5 * 65] * gb.y); o.w = cvt_pk_bf16(s[6 * 65] * gb.z, s[7 * 65] * gb.w);
        bf16_t* dst = WT + (size_t)(d0 + n) * K + k0 + 8 * c;
        if (WTHRU) asm volatile("global_store_dwordx4 %0, %1, off sc1\n\ts_nop 1" :: "v"(dst), "v"(o) : "memory");
        else *(u32x4*)dst = o; }
    asm volatile("s_waitcnt lgkmcnt(0)" ::: "memory");
}
__device__ __forceinline__ void row_to_bf16_rs(const float* xrow, bf16_t* orow, float* rs_out, int lane) {
    const f32x4* xr = (const f32x4*)xrow + lane;
    f32x4 v[4]; float s = 0.f;
#pragma unroll
    for (int j = 0; j < 4; ++j) { v[j] = xr[64 * j]; s += (v[j].x * v[j].x + v[j].y * v[j].y) + (v[j].z * v[j].z + v[j].w * v[j].w); }
    const float rs = 1.0f / sqrtf(wave_sum(s) * (1.f / DM) + RMS_EPS);
    u32x2* o8 = (u32x2*)orow + lane;
#pragma unroll
    for (int j = 0; j < 4; ++j) { u32x2 w; w.x = cvt_pk_bf16(v[j].x, v[j].y); w.y = cvt_pk_bf16(v[j].z, v[j].w); o8[64 * j] = w; }
    if (lane == 0) *rs_out = rs;
}

constexpr int KSTR = 136, VSTR = 216, KROWS = 208;
constexpr int ATT_VT_OFF = KROWS * KSTR * 2;
constexpr int ATT_SS_OFF = ATT_VT_OFF + 128 * VSTR * 2;
__device__ __forceinline__ void attn_unit(LAS unsigned char* lds, const bf16_t* PROJ, bf16_t* MERGED, const float* sinks, const float* g_attn, int u, int tid, int wid, int lane) {
    const int b = u >> 5, qb = u & 31;
    const int kb0 = 64 * qb - 144;
    LAS bf16_t* Ks = (LAS bf16_t*)lds;
    LAS bf16_t* Vt = (LAS bf16_t*)(lds + ATT_VT_OFF);
    LAS float* SS = (LAS float*)(lds + ATT_SS_OFF);
    const bf16_t* base = PROJ + (size_t)b * SEQ * INW;
    for (int task = tid; task < KROWS * 16; task += 512) {
        const int kr = task >> 4, cc = task & 15, tok = kb0 + kr;
        u32x4 v = *(const u32x4*)(base + (size_t)(tok < 0 ? 0 : tok) * INW + KOFF + 8 * cc);
        if (tok < 0) v = (u32x4){0u, 0u, 0u, 0u};
        *(LAS u32x4*)(Ks + kr * KSTR + 8 * cc) = v;
    }
    for (int task = tid; task < (KROWS / 2) * 16; task += 512) {
        const int kp = task % (KROWS / 2), dc = task / (KROWS / 2), tok = kb0 + 2 * kp;
        const int tokc = tok < 0 ? 0 : tok;
        u32x4 a0 = *(const u32x4*)(base + (size_t)tokc * INW + VOFF + 8 * dc), a1 = *(const u32x4*)(base + (size_t)(tokc + 1) * INW + VOFF + 8 * dc);
        if (tok < 0) { a0 = (u32x4){0u, 0u, 0u, 0u}; a1 = a0; }
#pragma unroll
        for (int e = 0; e < 8; ++e) {
            const unsigned w0 = a0[e >> 1], w1 = a1[e >> 1];
            const unsigned lo = (e & 1) ? (w0 >> 16) : (w0 & 0xffffu), hi = (e & 1) ? (w1 & 0xffff0000u) : (w1 << 16);
            *(LAS unsigned*)(Vt + (8 * dc + e) * VSTR + 2 * kp) = lo | hi;
        }
    }
    __syncthreads();
    const int h = wid, kvh = h >> 2, qq = lane & 15, g = lane >> 4;
    const float slope2 = fast_exp2(-(float)(h + 1)) * LOG2E, sink2 = sinks[h] * LOG2E;
    f32x4 O[4][4];
#pragma unroll
    for (int i = 0; i < 4; ++i) {
        const int tq = 64 * qb + 16 * i + qq;
        const bf16_t* qp = base + (size_t)tq * INW + h * 64 + 8 * g;
        const bf16x8 qf0 = *(const bf16x8*)qp, qf1 = *(const bf16x8*)(qp + 32);
        f32x4 S[9];
#pragma unroll
        for (int jb = 0; jb < 9; ++jb) {
            const LAS bf16_t* kp = Ks + (16 * i + 16 + 16 * jb + qq) * KSTR + kvh * 64 + 8 * g;
            const bf16x8 k0 = *(const LAS bf16x8*)kp, k1 = *(const LAS bf16x8*)(kp + 32);
            f32x4 s = (f32x4){0.f, 0.f, 0.f, 0.f};
            s = __builtin_amdgcn_mfma_f32_16x16x32_bf16(k0, qf0, s, 0, 0, 0);
            s = __builtin_amdgcn_mfma_f32_16x16x32_bf16(k1, qf1, s, 0, 0, 0);
            S[jb] = s;
        }
        float mx = sink2;
#pragma unroll
        for (int jb = 0; jb < 9; ++jb)
#pragma unroll
            for (int r = 0; r < 4; ++r) {
                const int kk = 4 * g + r, dist = 128 - 16 * jb + qq - kk, ktok = 64 * qb + 16 * i - 128 + 16 * jb + kk;
                const bool valid = (dist >= 0) && (dist < 128) && (ktok >= 0);
                float l = S[jb][r] * (0.125f * LOG2E) - slope2 * (float)dist;
                l = valid ? l : -INFINITY;
                S[jb][r] = l; mx = fmaxf(mx, l);
            }
        mx = fmaxf(mx, __shfl_xor(mx, 16)); mx = fmaxf(mx, __shfl_xor(mx, 32));
        float den = 0.f;
#pragma unroll
        for (int jb = 0; jb < 9; ++jb)
#pragma unroll
            for (int r = 0; r < 4; ++r) { const float p = fast_exp2(S[jb][r] - mx); den += p; S[jb][r] = p; }
        den += __shfl_xor(den, 16); den += __shfl_xor(den, 32);
        den += fast_exp2(sink2 - mx);
        const float inv = fast_rcp(den);
#pragma unroll
        for (int db = 0; db < 4; ++db) O[i][db] = (f32x4){0.f, 0.f, 0.f, 0.f};
#pragma unroll
        for (int ks2 = 0; ks2 < 5; ++ks2) {
            u32x4 pw;
            if (ks2 == 0) { pw.x = 0u; pw.y = 0u; } else { pw.x = cvt_pk_bf16(S[2 * ks2 - 1][0], S[2 * ks2 - 1][1]); pw.y = cvt_pk_bf16(S[2 * ks2 - 1][2], S[2 * ks2 - 1][3]); }
            pw.z = cvt_pk_bf16(S[2 * ks2][0], S[2 * ks2][1]); pw.w = cvt_pk_bf16(S[2 * ks2][2], S[2 * ks2][3]);
            const bf16x8 pf = __builtin_bit_cast(bf16x8, pw);
#pragma unroll
            for (int db = 0; db < 4; ++db) {
                const LAS bf16_t* vp = Vt + (kvh * 64 + 16 * (qq >> 2) + 4 * db + (qq & 3)) * VSTR + 16 * i + 32 * ks2 + 4 * g;
                const u32x2 lo = *(const LAS u32x2*)vp, hi = *(const LAS u32x2*)(vp + 16);
                const u32x4 vw = (u32x4){lo.x, lo.y, hi.x, hi.y};
                O[i][db] = __builtin_amdgcn_mfma_f32_16x16x32_bf16(__builtin_bit_cast(bf16x8, vw), pf, O[i][db], 0, 0, 0);
            }
        }
        float ssq = 0.f;
#pragma unroll
        for (int db = 0; db < 4; ++db) { O[i][db] = O[i][db] * inv; const f32x4 o = O[i][db]; ssq += (o.x * o.x + o.y * o.y) + (o.z * o.z + o.w * o.w); }
        ssq += __shfl_xor(ssq, 16); ssq += __shfl_xor(ssq, 32);
        if (g == 0) SS[(16 * i + qq) * 8 + h] = ssq;
    }
    __syncthreads();
#pragma unroll
    for (int i = 0; i < 4; ++i) {
        const f32x4 s0 = *(const LAS f32x4*)(SS + (16 * i + qq) * 8), s1 = *(const LAS f32x4*)(SS + (16 * i + qq) * 8 + 4);
        const float tot = (s0.x + s0.y) + (s0.z + s0.w) + (s1.x + s1.y) + (s1.z + s1.w);
        const float rs = __builtin_amdgcn_rsqf(tot * (1.f / 512.f) + RMS_EPS);
        bf16_t* orow = MERGED + (size_t)(b * SEQ + 64 * qb + 16 * i + qq) * DM + h * 64 + 16 * g;
        unsigned pk[8];
#pragma unroll
        for (int db = 0; db < 4; ++db) {
            const f32x4 gg = *(const f32x4*)(g_attn + h * 64 + 16 * g + 4 * db); const f32x4 o = O[i][db];
            pk[2 * db] = cvt_pk_bf16(o.x * rs * gg.x, o.y * rs * gg.y); pk[2 * db + 1] = cvt_pk_bf16(o.z * rs * gg.z, o.w * rs * gg.w);
        }
        *(u32x4*)orow = (u32x4){pk[0], pk[1], pk[2], pk[3]}; *(u32x4*)(orow + 8) = (u32x4){pk[4], pk[5], pk[6], pk[7]};
    }
    __syncthreads();
}

__device__ __forceinline__ void lru_unit(LAS unsigned char* lds, const bf16_t* PROJ, const bf16_t* WaT, const bf16_t* WxT, const float* convw, const float* convb, const float* ba, const float* bx, const float* sp,
                                         float* SUMM, unsigned* FLAG, const float* g_lru, bf16_t* MERGED, bool xl, int u, int tid, int wid, int lane) {
    const int b = u >> 5, c = u & 31, hd = wid, fr = lane & 15, g = lane >> 4;
    constexpr int HSTR = 520;
    LAS bf16_t* HLs = (LAS bf16_t*)lds; LAS bf16_t* ACs = (LAS bf16_t*)(lds + 64 * HSTR * 2);
    LAS float* C = (LAS float*)(lds + 2 * 64 * HSTR * 2);
    LAS float* Hs = C + 4096;
    C[tid] = convw[tid]; C[512 + tid] = convw[512 + tid]; C[1024 + tid] = convw[1024 + tid]; C[1536 + tid] = convw[1536 + tid];
    C[2048 + tid] = convb[tid]; C[2560 + tid] = ba[tid]; C[3072 + tid] = bx[tid]; C[3584 + tid] = sp[tid];
    bf16x8 wa[4][2], wx[4][2];
#pragma unroll
    for (int ob = 0; ob < 4; ++ob)
#pragma unroll
        for (int ks = 0; ks < 2; ++ks) {
            const size_t off = (size_t)(hd * 64 + 16 * (fr >> 2) + 4 * ob + (fr & 3)) * 64 + 16 * g + 8 * ks;
            wa[ob][ks] = *(const bf16x8*)(WaT + off); wx[ob][ks] = *(const bf16x8*)(WxT + off);
        }
    __syncthreads();
    f32x4 cH[4], cA[4];
#pragma unroll
    for (int ob = 0; ob < 4; ++ob) { cH[ob] = (f32x4){0.f, 0.f, 0.f, 0.f}; cA[ob] = (f32x4){1.f, 1.f, 1.f, 1.f}; }
    const int chb = hd * 64 + 16 * g;
    const bf16_t* lxb = PROJ + (size_t)b * SEQ * INW + LXOFF + chb;
#pragma unroll 1
    for (int tb = 0; tb < 4; ++tb) {
        const int t = 64 * c + 16 * tb + fr;
        u32x4 raw[4][2];
#pragma unroll
        for (int k = 0; k < 4; ++k) {
            const int tt = t - 3 + k, ttc = tt < 0 ? 0 : tt;
            raw[k][0] = *(const u32x4*)(lxb + (size_t)ttc * INW); raw[k][1] = *(const u32x4*)(lxb + (size_t)ttc * INW + 8);
            if (tt < 0) { raw[k][0] = (u32x4){0u, 0u, 0u, 0u}; raw[k][1] = raw[k][0]; }
        }
        float xc[16];
#pragma unroll
        for (int q = 0; q < 4; ++q) {
            f32x4 a = *(const LAS f32x4*)(C + 2048 + chb + 4 * q);
#pragma unroll
            for (int k = 0; k < 4; ++k) {
                const f32x4 w = *(const LAS f32x4*)(C + k * 512 + chb + 4 * q);
                const unsigned r0 = raw[k][q >> 1][2 * (q & 1)], r1 = raw[k][q >> 1][2 * (q & 1) + 1];
                a = a + w * (f32x4){bf_lo(r0), bf_hi(r0), bf_lo(r1), bf_hi(r1)};
            }
            xc[4 * q] = a.x; xc[4 * q + 1] = a.y; xc[4 * q + 2] = a.z; xc[4 * q + 3] = a.w;
        }
        bf16x8 xf[2];
#pragma unroll
        for (int ks = 0; ks < 2; ++ks) {
            u32x4 w; w.x = cvt_pk_bf16(xc[8 * ks], xc[8 * ks + 1]); w.y = cvt_pk_bf16(xc[8 * ks + 2], xc[8 * ks + 3]);
            w.z = cvt_pk_bf16(xc[8 * ks + 4], xc[8 * ks + 5]); w.w = cvt_pk_bf16(xc[8 * ks + 6], xc[8 * ks + 7]);
            xf[ks] = __builtin_bit_cast(bf16x8, w);
        }
        const size_t row = (size_t)b * SEQ + t;
#pragma unroll
        for (int ob = 0; ob < 4; ++ob) {
            f32x4 R = (f32x4){0.f, 0.f, 0.f, 0.f}, I = R;
            R = __builtin_amdgcn_mfma_f32_16x16x32_bf16(wa[ob][0], xf[0], R, 0, 0, 0); R = __builtin_amdgcn_mfma_f32_16x16x32_bf16(wa[ob][1], xf[1], R, 0, 0, 0);
            I = __builtin_amdgcn_mfma_f32_16x16x32_bf16(wx[ob][0], xf[0], I, 0, 0, 0); I = __builtin_amdgcn_mfma_f32_16x16x32_bf16(wx[ob][1], xf[1], I, 0, 0, 0);
            const f32x4 bav = *(const LAS f32x4*)(C + 2560 + chb + 4 * ob), bxv = *(const LAS f32x4*)(C + 3072 + chb + 4 * ob), spv = *(const LAS f32x4*)(C + 3584 + chb + 4 * ob);
            float hl[4], ac[4];
            f32x4 av4, uv4;
            {
                const f32x4 tr = (R + bav) * (-LOG2E), ti = (I + bxv) * (-LOG2E);
                f32x4 er, ei; er.x = fast_exp2(tr.x); er.y = fast_exp2(tr.y); er.z = fast_exp2(tr.z); er.w = fast_exp2(tr.w);
                ei.x = fast_exp2(ti.x); ei.y = fast_exp2(ti.y); ei.z = fast_exp2(ti.z); ei.w = fast_exp2(ti.w);
                const f32x4 dr = er + 1.0f, di = ei + 1.0f;
                f32x4 rg, ig; rg.x = fast_rcp(dr.x); rg.y = fast_rcp(dr.y); rg.z = fast_rcp(dr.z); rg.w = fast_rcp(dr.w);
                ig.x = fast_rcp(di.x); ig.y = fast_rcp(di.y); ig.z = fast_rcp(di.z); ig.w = fast_rcp(di.w);
                const f32x4 la2 = rg * spv * (-8.0f * LOG2E);
                f32x4 a4; a4.x = fast_exp2(la2.x); a4.y = fast_exp2(la2.y); a4.z = fast_exp2(la2.z); a4.w = fast_exp2(la2.w);
                f32x4 om = 1.0f - a4 * a4;
                om.x = fmaxf(om.x, 0.f); om.y = fmaxf(om.y, 0.f); om.z = fmaxf(om.z, 0.f); om.w = fmaxf(om.w, 0.f);
                f32x4 sq; sq.x = __builtin_amdgcn_sqrtf(om.x); sq.y = __builtin_amdgcn_sqrtf(om.y); sq.z = __builtin_amdgcn_sqrtf(om.z); sq.w = __builtin_amdgcn_sqrtf(om.w);
                const f32x4 xv = (f32x4){xc[4 * ob], xc[4 * ob + 1], xc[4 * ob + 2], xc[4 * ob + 3]};
                av4 = a4; uv4 = sq * ig * xv;
            }
            float av[4] = {av4.x, av4.y, av4.z, av4.w}, uv[4] = {uv4.x, uv4.y, uv4.z, uv4.w};
#define LRU_SCAN_STEP(SH) asm volatile("s_nop 1\n\t" \
                "v_fmac_f32_dpp %0, %0, %4 row_shr:" #SH " row_mask:0xf bank_mask:0xf\n\tv_fmac_f32_dpp %1, %1, %5 row_shr:" #SH " row_mask:0xf bank_mask:0xf\n\t" \
                "v_fmac_f32_dpp %2, %2, %6 row_shr:" #SH " row_mask:0xf bank_mask:0xf\n\tv_fmac_f32_dpp %3, %3, %7 row_shr:" #SH " row_mask:0xf bank_mask:0xf\n\t" \
                "v_mul_f32_dpp %4, %4, %4 row_shr:" #SH " row_mask:0xf bank_mask:0xf\n\tv_mul_f32_dpp %5, %5, %5 row_shr:" #SH " row_mask:0xf bank_mask:0xf\n\t" \
                "v_mul_f32_dpp %6, %6, %6 row_shr:" #SH " row_mask:0xf bank_mask:0xf\n\tv_mul_f32_dpp %7, %7, %7 row_shr:" #SH " row_mask:0xf bank_mask:0xf\n\ts_nop 1" \
                : "+v"(uv[0]), "+v"(uv[1]), "+v"(uv[2]), "+v"(uv[3]), "+v"(av[0]), "+v"(av[1]), "+v"(av[2]), "+v"(av[3]))
            LRU_SCAN_STEP(1); LRU_SCAN_STEP(2); LRU_SCAN_STEP(4); LRU_SCAN_STEP(8);
#undef LRU_SCAN_STEP
#pragma unroll
            for (int r = 0; r < 4; ++r) {
                hl[r] = uv[r] + av[r] * cH[ob][r]; ac[r] = av[r] * cA[ob][r];
                cH[ob][r] = __shfl(hl[r], (lane & 48) | 15); cA[ob][r] = __shfl(ac[r], (lane & 48) | 15);
            }
            { LAS bf16_t* hr = HLs + (16 * tb + fr) * HSTR + chb + 4 * ob; LAS bf16_t* ar = ACs + (16 * tb + fr) * HSTR + chb + 4 * ob;
              *(LAS u32x2*)hr = (u32x2){cvt_pk_bf16(hl[0], hl[1]), cvt_pk_bf16(hl[2], hl[3])}; *(LAS u32x2*)ar = (u32x2){cvt_pk_bf16(ac[0], ac[1]), cvt_pk_bf16(ac[2], ac[3])}; }
        }
    }
    const int lane_t = (int)__builtin_amdgcn_mbcnt_hi(~0u, __builtin_amdgcn_mbcnt_lo(~0u, 0u));
    const int tid_t = wid * 64 + lane_t, fr_t = lane_t & 15, chb_t = hd * 64 + 16 * (lane_t >> 4);
    if (fr_t == 0) {
        unsigned* sa = (unsigned*)(SUMM + ((size_t)(b * 32 + c) * 2 + 0) * 512 + chb_t); unsigned* sh = sa + 512;
        if (xl) {
#pragma unroll
            for (int ob = 0; ob < 4; ++ob) { *(f32x4*)(sa + 4 * ob) = cA[ob]; *(f32x4*)(sh + 4 * ob) = cH[ob]; }
        } else {
#pragma unroll
        for (int ob = 0; ob < 4; ++ob)
#pragma unroll
            for (int r = 0; r < 4; ++r) {
                __hip_atomic_store(sa + 4 * ob + r, __float_as_uint(cA[ob][r]), __ATOMIC_RELAXED, __HIP_MEMORY_SCOPE_AGENT);
                __hip_atomic_store(sh + 4 * ob + r, __float_as_uint(cH[ob][r]), __ATOMIC_RELAXED, __HIP_MEMORY_SCOPE_AGENT);
            }
        }
    }
    asm volatile("s_waitcnt vmcnt(0) lgkmcnt(0)" ::: "memory");
    __syncthreads();
    if (tid_t == 0) __hip_atomic_store(FLAG + 16 * u, 1u, __ATOMIC_RELAXED, __HIP_MEMORY_SCOPE_AGENT);
    if (tid_t < c) {
        unsigned sp = 0;
        while (__hip_atomic_load(FLAG + 16 * (b * 32 + tid_t), __ATOMIC_RELAXED, __HIP_MEMORY_SCOPE_AGENT) == 0u) { __builtin_amdgcn_s_sleep(2); if (++sp > (1u << 22)) break; }
    }
    __syncthreads();
    {
        float H = 0.f;
        for (int c0 = 0; c0 < c; c0 += 32) {
            float sa[32], sh[32];
#pragma unroll
            for (int q = 0; q < 32; ++q) { const int cp = (c0 + q < c) ? (c0 + q) : 0; const unsigned* sp_ = (const unsigned*)SUMM + ((size_t)(b * 32 + cp) * 2) * 512 + tid_t;
                if (xl) { sa[q] = __uint_as_float(sp_[0]); sh[q] = __uint_as_float(sp_[512]); }
                else { sa[q] = __uint_as_float(__hip_atomic_load(sp_, __ATOMIC_RELAXED, __HIP_MEMORY_SCOPE_AGENT)); sh[q] = __uint_as_float(__hip_atomic_load(sp_ + 512, __ATOMIC_RELAXED, __HIP_MEMORY_SCOPE_AGENT)); } }
#pragma unroll
            for (int q = 0; q < 32; ++q) if (c0 + q < c) H = sa[q] * H + sh[q];
        }
        Hs[tid_t] = H;
    }
    __syncthreads();
    {
        const f32x4 H0 = *(const LAS f32x4*)(Hs + 8 * lane_t), H1 = *(const LAS f32x4*)(Hs + 8 * lane_t + 4);
        const f32x4 g0 = *(const f32x4*)(g_lru + 8 * lane_t), g1 = *(const f32x4*)(g_lru + 8 * lane_t + 4);
#pragma unroll
        for (int j = 0; j < 8; ++j) {
            const int tk = 8 * wid + j; const size_t row = (size_t)b * SEQ + 64 * c + tk;
            const u32x4 hlw = *(const LAS u32x4*)(HLs + tk * HSTR + 8 * lane_t), acw = *(const LAS u32x4*)(ACs + tk * HSTR + 8 * lane_t), lgw = *(const u32x4*)(PROJ + row * INW + LGOFF + 8 * lane_t);
            const f32x4 hl0 = (f32x4){bf_lo(hlw.x), bf_hi(hlw.x), bf_lo(hlw.y), bf_hi(hlw.y)}, hl1 = (f32x4){bf_lo(hlw.z), bf_hi(hlw.z), bf_lo(hlw.w), bf_hi(hlw.w)};
            const f32x4 ac0 = (f32x4){bf_lo(acw.x), bf_hi(acw.x), bf_lo(acw.y), bf_hi(acw.y)}, ac1 = (f32x4){bf_lo(acw.z), bf_hi(acw.z), bf_lo(acw.w), bf_hi(acw.w)};
            const f32x4 lg0 = (f32x4){bf_lo(lgw.x), bf_hi(lgw.x), bf_lo(lgw.y), bf_hi(lgw.y)}, lg1 = (f32x4){bf_lo(lgw.z), bf_hi(lgw.z), bf_lo(lgw.w), bf_hi(lgw.w)};
            const f32x4 v0 = (hl0 + ac0 * H0) * gelu_tanh4(lg0), v1 = (hl1 + ac1 * H1) * gelu_tanh4(lg1);
            const f32x4 q = v0 * v0 + v1 * v1;
            const float rs = __builtin_amdgcn_rsqf(wave_sum((q.x + q.y) + (q.z + q.w)) * (1.f / 512.f) + RMS_EPS);
            const f32x4 o0 = v0 * rs * g0, o1 = v1 * rs * g1;
            u32x4 w;
            w.x = cvt_pk_bf16(o0.x, o0.y); w.y = cvt_pk_bf16(o0.z, o0.w); w.z = cvt_pk_bf16(o1.x, o1.y); w.w = cvt_pk_bf16(o1.z, o1.w);
            *(u32x4*)(MERGED + row * DM + 512 + 8 * lane_t) = w;
        }
    }
    __syncthreads();
}

__device__ __forceinline__ void lru_final_unit(LAS unsigned char* lds, const bf16_t* PROJ, const bf16_t* HL, const bf16_t* ACUM, const float* SUMM, const float* g_lru, bf16_t* MERGED,
                                               int u, int tid, int wid, int lane) {
    const int b = u >> 5, c = u & 31;
    LAS float* Hs = (LAS float*)lds;
    {
        float H = 0.f;
        for (int c0 = 0; c0 < c; c0 += 16) {
            float sa[16], sh[16];
#pragma unroll
            for (int q = 0; q < 16; ++q) { const int cp = (c0 + q < c) ? (c0 + q) : 0; const float* s = SUMM + ((size_t)(b * 32 + cp) * 2) * 512 + tid; sa[q] = s[0]; sh[q] = s[512]; }
#pragma unroll
            for (int q = 0; q < 16; ++q) if (c0 + q < c) H = sa[q] * H + sh[q];
        }
        Hs[tid] = H;
    }
    __syncthreads();
    const f32x4 H0 = *(const LAS f32x4*)(Hs + 8 * lane), H1 = *(const LAS f32x4*)(Hs + 8 * lane + 4);
    const f32x4 g0 = *(const f32x4*)(g_lru + 8 * lane), g1 = *(const f32x4*)(g_lru + 8 * lane + 4);
#pragma unroll
    for (int j = 0; j < 8; ++j) {
        const size_t row = (size_t)b * SEQ + 64 * c + 8 * wid + j;
        const u32x4 hlw = *(const u32x4*)(HL + row * 512 + 8 * lane), acw = *(const u32x4*)(ACUM + row * 512 + 8 * lane), lgw = *(const u32x4*)(PROJ + row * INW + LGOFF + 8 * lane);
        float v[8]; float ssq = 0.f;
#pragma unroll
        for (int e = 0; e < 8; ++e) {
            const unsigned hw = hlw[e >> 1], aw = acw[e >> 1], gw = lgw[e >> 1];
            const float hl = (e & 1) ? bf_hi(hw) : bf_lo(hw), ac = (e & 1) ? bf_hi(aw) : bf_lo(aw), lg = (e & 1) ? bf_hi(gw) : bf_lo(gw);
            const float Hc = e < 4 ? H0[e & 3] : H1[e & 3];
            const float hv = hl + ac * Hc;
            v[e] = hv * gelu_tanh(lg); ssq += v[e] * v[e];
        }
        const float rs = 1.0f / sqrtf(wave_sum(ssq) * (1.f / 512.f) + RMS_EPS);
        u32x4 w;
        w.x = cvt_pk_bf16(v[0] * rs * g0.x, v[1] * rs * g0.y); w.y = cvt_pk_bf16(v[2] * rs * g0.z, v[3] * rs * g0.w);
        w.z = cvt_pk_bf16(v[4] * rs * g1.x, v[5] * rs * g1.y); w.w = cvt_pk_bf16(v[6] * rs * g1.z, v[7] * rs * g1.w);
        *(u32x4*)(MERGED + row * DM + 512 + 8 * lane) = w;
    }
    __syncthreads();
}

#define XB_TMO      128
#define XB_XCNT(j)  (256  + 64 * (j))
#define XB_XSUB(j)  (1280 + 64 * (j))
#define XB_XGEN(j)  (2304 + 64 * (j))
#define XB_TOP      3328
#define XB_TOPGEN   3392
#define XCD_BAR_WORDS 3456
#define XB_SPIN_CAP (1u << 18)
__device__ __forceinline__ unsigned xb_ld(unsigned* p)              { return __hip_atomic_load(p, __ATOMIC_RELAXED, __HIP_MEMORY_SCOPE_AGENT); }
__device__ __forceinline__ unsigned xb_add(unsigned* p, unsigned v) { return __hip_atomic_fetch_add(p, v, __ATOMIC_RELAXED, __HIP_MEMORY_SCOPE_AGENT); }
__device__ __forceinline__ unsigned xb_xcc_id() { return (unsigned)__builtin_amdgcn_s_getreg((3 << 11) | 20) & 0xFu; }
#define XB_SPIN(cond, bar) do { unsigned _sp = 0; while (cond) { __builtin_amdgcn_s_sleep(1); \
    if ((++_sp & 255u) == 0u) { if (xb_ld(&(bar)[XB_TMO])) break; if (_sp > XB_SPIN_CAP) { atomicAdd(&(bar)[XB_TMO], 1u); break; } } } } while (0)
#define SEAM(k) SEAM2(k, (k) + 1)
struct XcdBarrier { unsigned* bar; unsigned x; volatile LAS unsigned* st; };
__device__ __forceinline__ XcdBarrier xcd_barrier_post(unsigned* bar, volatile LAS unsigned* st) {
    XcdBarrier b; b.bar = bar; b.x = xb_xcc_id(); b.st = st;
    if (threadIdx.x == 0) st[2] = xb_add(&bar[XB_XCNT(b.x)], 1u);
    return b;
}
__device__ __forceinline__ void xcd_barrier_complete(unsigned* bar, unsigned x, unsigned& nloc, unsigned& nx) {
    const unsigned G = gridDim.x * gridDim.y * gridDim.z;
    unsigned sum, cnt, mine, sp = 0u;
    for (;;) {
        sum = 0u; cnt = 0u; mine = 0u;
#pragma unroll
        for (unsigned j = 0; j < 16; ++j) { const unsigned c = xb_ld(&bar[XB_XCNT(j)]); sum += c; cnt += (c > 0u) ? 1u : 0u; mine = (j == x) ? c : mine; }
        if (sum == G) break;
        __builtin_amdgcn_s_sleep(1);
        if ((++sp & 255u) == 0u) { if (xb_ld(&bar[XB_TMO])) break; if (sp > XB_SPIN_CAP) { atomicAdd(&bar[XB_TMO], 1u); break; } }
    }
    nloc = mine > 0u ? mine : 1u; nx = cnt > 0u ? cnt : 1u;
}
__device__ __forceinline__ void xcd_barrier(const XcdBarrier& b) {
    asm volatile("s_waitcnt vmcnt(0)" ::: "memory");
    __syncthreads();
    if (threadIdx.x == 0) {
        unsigned* bar = b.bar;
        __builtin_amdgcn_s_waitcnt(0);
        unsigned nloc = b.st[0], nx = b.st[1];
        if (nloc == 0u) { xcd_barrier_complete(bar, b.x, nloc, nx); b.st[0] = nloc; b.st[1] = nx; }
        const unsigned old = xb_add(&bar[XB_XSUB(b.x)], 1u);
        const unsigned gen = old / nloc;
        if (old + 1u == (gen + 1u) * nloc) {
            __builtin_amdgcn_fence(__ATOMIC_RELEASE, "agent");
            asm volatile("s_waitcnt vmcnt(0)" ::: "memory");
            const unsigned og = xb_add(&bar[XB_TOP], 1u);
            const unsigned tg = og / nx;
            if (og + 1u == (tg + 1u) * nx) xb_add(&bar[XB_TOPGEN], 1u);
            else XB_SPIN(xb_ld(&bar[XB_TOPGEN]) == tg, bar);
            __builtin_amdgcn_fence(__ATOMIC_ACQUIRE, "agent");
            xb_add(&bar[XB_XGEN(b.x)], 1u);
            asm volatile("s_waitcnt vmcnt(0)" ::: "memory");
        } else {
            XB_SPIN(xb_ld(&bar[XB_XGEN(b.x)]) == gen, bar);
            __builtin_amdgcn_fence(__ATOMIC_ACQUIRE, "agent");
            asm volatile("s_waitcnt vmcnt(0)" ::: "memory");
        }
    }
    __syncthreads();
}

#define XL_SUB(j) (3456 + 32 * (j))
#define XL_GEN(j) (3456 + 256 + 32 * (j))
__device__ __forceinline__ void xcc_local_barrier(const XcdBarrier& b) {
    asm volatile("s_waitcnt vmcnt(0)" ::: "memory");
    __syncthreads();
    if (threadIdx.x == 0) {
        unsigned* bar = b.bar;
        __builtin_amdgcn_s_waitcnt(0);
        const unsigned nloc = b.st[0];
        const unsigned old = xb_add(&bar[XL_SUB(b.x)], 1u);
        const unsigned gen = old / nloc;
        if (old + 1u == (gen + 1u) * nloc) xb_add(&bar[XL_GEN(b.x)], 1u);
        else XB_SPIN(xb_ld(&bar[XL_GEN(b.x)]) == gen, bar);
        __builtin_amdgcn_fence(__ATOMIC_ACQUIRE, "agent");
        asm volatile("s_waitcnt vmcnt(0)" ::: "memory");
    }
    __syncthreads();
}

struct Args { const float* in[21]; float* out; unsigned char* ws; int ph_lo, ph_hi; };
constexpr int N_PHASES = 10;

__global__ void __launch_bounds__(512, 2) mk_fwd(Args a) {
    extern __shared__ __attribute__((aligned(16))) unsigned char lds_raw[];
    LAS unsigned char* lds = (LAS unsigned char*)lds_raw;
    const int tid = threadIdx.x, lane = tid & 63, wid = __builtin_amdgcn_readfirstlane(tid >> 6);
    const int G = gridDim.x, bid = blockIdx.x;
    const int gw = bid * 8 + wid, NGW = G * 8;
    unsigned char* ws = a.ws;
    const float* x = a.in[0];
    bf16_t* WinT = (bf16_t*)(ws + WS_WIN); bf16_t* WoutT = (bf16_t*)(ws + WS_WOUT); bf16_t* WupT = (bf16_t*)(ws + WS_WUP); bf16_t* WdnT = (bf16_t*)(ws + WS_WDN);
    bf16_t* WaT = (bf16_t*)(ws + WS_WAT); bf16_t* WxT = WaT + 8 * 64 * 64; float* SP = (float*)(ws + WS_WAT + 131072);
    float* SUMM = (float*)(ws + WS_SUMM);
    bf16_t* HN = (bf16_t*)(ws + WS_HN); bf16_t* PROJ = (bf16_t*)(ws + WS_R1); float* Y = (float*)(ws + WS_R1);
    bf16_t* MERGED = (bf16_t*)(ws + WS_MERGED); bf16_t* HL = (bf16_t*)(ws + WS_HL); bf16_t* ACUM = (bf16_t*)(ws + WS_ACUM);
    bf16_t* GB = (bf16_t*)(ws + WS_G); bf16_t* EDGE = (bf16_t*)(ws + WS_EDGE);
    float* RS1 = (float*)(ws + WS_XB + 3 * M * 4 * 4); float* RS2 = RS1 + M;
    float* out = a.out; bf16_t* X1B = (bf16_t*)(ws + WS_MERGED);
    unsigned* XB0 = (unsigned*)(ws + WS_XB); unsigned* XB1 = XB0 + M * 4; unsigned* XB2 = XB1 + M * 4;
    unsigned* WUPCNT = (unsigned*)ws + 4032;
    unsigned* CNT0 = (unsigned*)(ws + 16384); unsigned* CNT1 = CNT0 + 64 * 64; unsigned* CNT2 = CNT1 + 64 * 64; unsigned* CNT3 = CNT2 + 64 * 64; unsigned* FLAGS = CNT3 + 64 * 64;
    const int lo = a.ph_lo, hi = a.ph_hi;
    volatile LAS unsigned* MISC = (volatile LAS unsigned*)(lds + LDS_BYTES - 256);
    if (tid < 32) MISC[tid] = 0u;
    __syncthreads();
    XcdBarrier bar; bar.bar = (unsigned*)ws; bar.x = 0; bar.st = MISC + 8;
    if (hi - lo > 1) bar = xcd_barrier_post((unsigned*)ws, MISC + 8);
#ifndef PH_MASK
#define PH_MASK 0x3ff
#endif
#define IN(k) (((PH_MASK >> (k)) & 1) && lo <= (k) && (k) < hi)
#ifndef PROBE_DUP
#define PROBE_DUP 0x0
#endif
#define REP(k) for (int rep_ = 0; rep_ < ((((PROBE_DUP) >> (k)) & 1) ? 3 : 1); ++rep_)
#ifndef PROBE_SYNC
#define PROBE_SYNC 0
#endif
#define SEAM2(k, k2) do { if (IN(k) && IN(k2)) { xcd_barrier(bar); if (PROBE_SYNC && (k) == 0) for (int q_ = 0; q_ < 10; ++q_) xcd_barrier(bar); } } while (0)

    if (IN(0)) REP(0) {
        LAS float* scr = (LAS float*)(lds + wid * 16640);
        constexpr int I_IN = (DM / 64) * (INW / 64), I_OUT = (DM / 64) * (DM / 64), I_DN = (DFF / 64) * (DM / 64);
        for (int it = gw; it < I_IN + I_OUT + I_DN; it += NGW) {
            int r = it;
            if (r < I_IN) { p0_transpose_item<false>(a.in[2], DM, INW, WinT, scr, r, lane, a.in[1]); continue; } r -= I_IN;
            if (r < I_OUT) { p0_transpose_item<false>(a.in[13], DM, DM, WoutT, scr, r, lane); continue; } r -= I_OUT;
            p0_transpose_item<false>(a.in[19], DFF, DM, WdnT, scr, r, lane);
        }
        for (int i = bid * 512 + tid; i < 2 * 8 * 64 * 64; i += G * 512) {
            const int mat = i >> 15, r = i & 32767, hh = r >> 12, o = (r >> 6) & 63, ii = r & 63;
            const float v = (mat ? a.in[8] : a.in[6])[(hh * 64 + ii) * 64 + o];
            (mat ? WxT : WaT)[r] = (bf16_t)(cvt_pk_bf16(v, 0.f) & 0xffffu);
        }
        for (int i = bid * 512 + tid; i < 512; i += G * 512) SP[i] = log1pf(expf(-a.in[10][i]));
        for (int m = gw; m < M; m += NGW) row_to_bf16_rs(x + (size_t)m * DM, HN + (size_t)m * DM, RS1 + m, lane);
        __syncthreads();
    }
    SEAM(0);
    int vb = bid; bool xlocal = false;
    if (hi - lo > 1) {
        if (tid == 0) {
            bool ok = (G == 256);
            for (unsigned j = 0; j < 16; ++j) { const unsigned cn = xb_ld(&bar.bar[XB_XCNT(j)]); ok = ok && (cn == (j < 8 ? (unsigned)(G / 8) : 0u)); }
            MISC[3 + 8] = ok ? 1u : 0u;
        }
        __syncthreads();
        xlocal = MISC[3 + 8] != 0u;
        if (xlocal) vb = (int)MISC[2 + 8] * 8 + (int)bar.x;
    }
    vb = __builtin_amdgcn_readfirstlane(vb);
#define SEAML(k, k2) do { if (IN(k) && IN(k2)) { if (xlocal) xcc_local_barrier(bar); else xcd_barrier(bar); } } while (0)
    if (IN(1)) REP(1) {
        pg8::Gemm g{HN, WinT, M, INW, DM}; pg8::StaticOrder S; S.init(M, INW, G, vb);
        pg8::EpiBf16 E{PROJ, INW, RS1};
        pg8::gemm_phase<pg8::EpiBf16, pg8::StaticOrder, true, true>(lds, g, S, E);
        {
            constexpr int NU = (M / 256) * (INW / 256);
            const bool split = (G < NU) && (2 * G > NU);
            const int f0 = split ? (NU - G) : 0, nf = G - f0;
            if (vb >= f0) {
                LAS float* scr = (LAS float*)(lds + wid * 16640);
                constexpr int I_UP = (DM / 64) * (NUP / 64);
                for (int it = (vb - f0) * 8 + wid; it < I_UP; it += nf * 8) p0_transpose_item<true, true>(a.in[16], DM, NUP, WupT, scr, it, lane, a.in[15]);
                asm volatile("s_waitcnt vmcnt(0)" ::: "memory");
                __syncthreads();
                if (tid == 0) __hip_atomic_fetch_add(WUPCNT, 1u, __ATOMIC_RELAXED, __HIP_MEMORY_SCOPE_AGENT);
            }
        }
    }
    SEAML(1, 2);
    if (IN(2)) REP(2) {
#ifndef NO_ATTN
        { const int u = (vb & 7) * 32 + (vb >> 3); attn_unit(lds, PROJ, MERGED, a.in[3], a.in[11], u, tid, wid, lane); }
#endif
#ifndef NO_LRU
        { const int u = (vb & 7) * 32 + (vb >> 3); lru_unit(lds, PROJ, WaT, WxT, a.in[4], a.in[5], a.in[7], a.in[9], SP, SUMM, FLAGS, a.in[12], MERGED, xlocal, u, tid, wid, lane); }
#endif
    }
    SEAML(2, 4);
    if (IN(4)) REP(4) {
        pg8::Gemm g{MERGED, WoutT, M, DM, DM}; pg8::StaticOrder S; S.init(M, DM, G, vb);
        pg8::PanelRms st1{XB0, CNT0}, st2{XB1, CNT1};
        pg8::EpiRmsResRms E{HN, X1B, (float*)XB1, a.in[14], st1, st2};
        pg8::gemm_phase<pg8::EpiRmsResRms, pg8::StaticOrder, false, true>(lds, g, S, E);
    }
    SEAML(4, 6);
    if (IN(6)) REP(6) {
        {
            constexpr int NU1 = (M / 256) * (INW / 256);
            const unsigned want = (unsigned)(((G < NU1) && (2 * G > NU1)) ? (2 * G - NU1) : G);
            if (tid == 0) { unsigned sp = 0; while (__hip_atomic_load(WUPCNT, __ATOMIC_RELAXED, __HIP_MEMORY_SCOPE_AGENT) < want) { __builtin_amdgcn_s_sleep(2); if (++sp > (1u << 22)) break; } }
            __syncthreads();
        }
        pg8::Gemm g{X1B, WupT, M, NUP, DM}; pg8::HalfTailOrder S; S.init(M, NUP, G, vb);
        pg8::EpiConvGate E{GB, EDGE, a.in[17], a.in[18], (const float*)XB1};
        pg8::gemm_phase<pg8::EpiConvGate, pg8::HalfTailOrder, true, true>(lds, g, S, E);
    }
    SEAML(6, 8);
    if (IN(8)) REP(8) {
        pg8::Gemm g{GB, WdnT, M, DM, DFF}; pg8::StaticOrder S; S.init(M, DM, G, vb);
        {
            const float* cw = a.in[17]; const float* cb = a.in[18];
            pg8::Unit uu;
            if (S.next(0, uu)) {
                const int B = 4 * uu.pm + uu.pn;
                const bool zero = (B % 32) == 0; const int Bp = zero ? B : B - 1;
#pragma unroll 3
                for (int idx = tid; idx < 2 * (DFF / 4); idx += 512) {
                    const int rsel = idx >= (DFF / 4) ? 1 : 0, ch = 4 * (idx - rsel * (DFF / 4));
                    f32x4 cv[2];
#pragma unroll
                    for (int gv = 0; gv < 2; ++gv) {
                        const int col = gv * DFF + ch;
                        const u32x2 r2 = *(const u32x2*)(EDGE + ((size_t)(Bp * 4 + 2) * 2 + gv) * DFF + ch), r1 = *(const u32x2*)(EDGE + ((size_t)(Bp * 4 + 3) * 2 + gv) * DFF + ch);
                        const u32x2 q0 = *(const u32x2*)(EDGE + ((size_t)(B * 4 + 0) * 2 + gv) * DFF + ch), q1 = *(const u32x2*)(EDGE + ((size_t)(B * 4 + 1) * 2 + gv) * DFF + ch);
                        f32x4 fm2 = (f32x4){bf_lo(r2.x), bf_hi(r2.x), bf_lo(r2.y), bf_hi(r2.y)}, fm1 = (f32x4){bf_lo(r1.x), bf_hi(r1.x), bf_lo(r1.y), bf_hi(r1.y)};
                        if (zero) { fm2 = (f32x4){0.f, 0.f, 0.f, 0.f}; fm1 = fm2; }
                        const f32x4 f0 = (f32x4){bf_lo(q0.x), bf_hi(q0.x), bf_lo(q0.y), bf_hi(q0.y)}, f1 = (f32x4){bf_lo(q1.x), bf_hi(q1.x), bf_lo(q1.y), bf_hi(q1.y)};
                        const f32x4 w0 = *(const f32x4*)(cw + col), w1 = *(const f32x4*)(cw + NUP + col), w2 = *(const f32x4*)(cw + 2 * NUP + col), bb = *(const f32x4*)(cb + col);
                        cv[gv] = rsel == 0 ? (w0 * fm2 + w1 * fm1 + w2 * f0 + bb) : (w0 * fm1 + w1 * f0 + w2 * f1 + bb);
                    }
                    const f32x4 go = gelu_tanh4(cv[0]) * cv[1];
                    u32x2 w; w.x = cvt_pk_bf16(go.x, go.y); w.y = cvt_pk_bf16(go.z, go.w);
                    *(u32x2*)(GB + (size_t)(64 * B + rsel) * DFF + ch) = w;
                }
                asm volatile("s_waitcnt vmcnt(0)" ::: "memory");
                __syncthreads();
                if (tid == 0) {
                    if (!xlocal) { __builtin_amdgcn_fence(__ATOMIC_RELEASE, "agent"); asm volatile("s_waitcnt vmcnt(0)" ::: "memory"); }
                    __hip_atomic_fetch_add(CNT3 + 64 * uu.pm, 1u, __ATOMIC_RELAXED, __HIP_MEMORY_SCOPE_AGENT);
                    unsigned sp = 0;
                    while (__hip_atomic_load(CNT3 + 64 * uu.pm, __ATOMIC_RELAXED, __HIP_MEMORY_SCOPE_AGENT) < 4u) { __builtin_amdgcn_s_sleep(2); if (++sp > (1u << 22)) break; }
                    __builtin_amdgcn_fence(__ATOMIC_ACQUIRE, "agent");
                    asm volatile("s_waitcnt vmcnt(0)" ::: "memory");
                }
                __syncthreads();
            }
        }
        pg8::PanelRms st{XB2, CNT2};
        pg8::EpiRmsRes E{X1B, out, a.in[20], st};
        pg8::gemm_phase<pg8::EpiRmsRes, pg8::StaticOrder, false, true>(lds, g, S, E);
    }
#undef IN
#undef SEAM
}

extern "C" void kernel_launch(void* const* d_in, const int* in_sizes, int n_in, void* d_out, int out_size, void* d_ws, size_t ws_size, hipStream_t stream) {
    static int grid = 0;
    if (grid == 0) {
        if (n_in != 21 || out_size != M * DM || ws_size < WS_END) { fprintf(stderr, "kernel_launch: unexpected problem shape (n_in %d out %d ws %zu)\n", n_in, out_size, ws_size); grid = -1; return; }
        int dev = 0, cus = 0, per_cu = 0;
        hipGetDevice(&dev); hipDeviceGetAttribute(&cus, hipDeviceAttributeMultiprocessorCount, dev);
        if (hipFuncSetAttribute((const void*)mk_fwd, hipFuncAttributeMaxDynamicSharedMemorySize, LDS_BYTES) != hipSuccess) { fprintf(stderr, "kernel_launch: hipFuncSetAttribute failed\n"); grid = -1; return; }
        if (hipOccupancyMaxActiveBlocksPerMultiprocessor(&per_cu, (const void*)mk_fwd, 512, LDS_BYTES) != hipSuccess || per_cu < 1) { fprintf(stderr, "kernel_launch: occupancy query says %d\n", per_cu); per_cu = 1; }
        (void)hipGetLastError();
        grid = cus * 1;
        if (grid > 256) grid = 256;
    }
    if (grid < 0) return;
    Args a{};
    for (int i = 0; i < 21; ++i) a.in[i] = (const float*)d_in[i];
    a.out = (float*)d_out; a.ws = (unsigned char*)d_ws;
#if MK_N_LAUNCHES == 1
    if (hipMemsetAsync(d_ws, 0, 16384 + 4 * 64 * 64 * 4 + 256 * 16 * 4, stream) != hipSuccess) { fprintf(stderr, "kernel_launch: memset failed\n"); return; }
    a.ph_lo = 0; a.ph_hi = N_PHASES;
    void* args[] = {&a};
    hipError_t e = hipLaunchCooperativeKernel((const void*)mk_fwd, dim3(grid), dim3(512), args, LDS_BYTES, stream);
    if (e != hipSuccess) fprintf(stderr, "cooperative launch failed: %s (grid %d)\n", hipGetErrorString(e), grid);
#else
    for (int p = 0; p < N_PHASES; ++p) { a.ph_lo = p; a.ph_hi = p + 1; hipLaunchKernelGGL(mk_fwd, dim3(grid), dim3(512), LDS_BYTES, stream, a); }
#endif
}
```

```cpp
#include <hip/hip_runtime.h>
#include <hip/hip_cooperative_groups.h>
#include <cstdio>
#include <cstdint>
namespace cg = cooperative_groups;

#ifndef MK_N_LAUNCHES
#define MK_N_LAUNCHES 1
#endif

#define LAS __attribute__((address_space(3)))
typedef unsigned short bf16_t;
typedef short bf16x8 __attribute__((ext_vector_type(8)));
typedef float f32x4 __attribute__((ext_vector_type(4)));
typedef float f32x2 __attribute__((ext_vector_type(2)));
typedef unsigned u32x4 __attribute__((ext_vector_type(4)));
typedef unsigned u32x2 __attribute__((ext_vector_type(2)));

constexpr int BATCH = 8, SEQ = 2048, DM = 1024, M = BATCH * SEQ;
constexpr int INW = 1792, DFF = 2816, NUP = 2 * DFF;
constexpr int KOFF = 512, VOFF = 640, LXOFF = 768, LGOFF = 1280;
constexpr float RMS_EPS = 1e-6f;
constexpr float LOG2E = 1.4426950408889634f;

constexpr size_t MiB = 1u << 20;
constexpr size_t WS_WIN = 1 * MiB;
constexpr size_t WS_WOUT = 5 * MiB;
constexpr size_t WS_WUP = 7 * MiB;
constexpr size_t WS_WDN = 18 * MiB;
constexpr size_t WS_WAT = 23 * MiB + 512 * 1024;
constexpr size_t WS_SUMM = 24 * MiB;
constexpr size_t WS_HN = 26 * MiB;
constexpr size_t WS_R1 = 58 * MiB;
constexpr size_t WS_MERGED = 122 * MiB;
constexpr size_t WS_HL = 154 * MiB;
constexpr size_t WS_ACUM = 170 * MiB;
constexpr size_t WS_G = 154 * MiB;
constexpr size_t WS_EDGE = 242 * MiB;
constexpr size_t WS_XB = 25 * MiB;
constexpr size_t WS_END = 254 * MiB;

constexpr int LDS_BYTES = 163840;

__device__ __forceinline__ unsigned cvt_pk_bf16(float lo, float hi) { unsigned r; asm volatile("v_cvt_pk_bf16_f32 %0, %1, %2" : "=v"(r) : "v"(lo), "v"(hi)); return r; }
__device__ __forceinline__ float bf_lo(unsigned w) { return __uint_as_float(w << 16); }
__device__ __forceinline__ float bf_hi(unsigned w) { return __uint_as_float(w & 0xffff0000u); }
__device__ __forceinline__ float fast_exp2(float x) { return __builtin_amdgcn_exp2f(x); }
__device__ __forceinline__ float fast_rcp(float x) { return __builtin_amdgcn_rcpf(x); }
__device__ __forceinline__ float sigmoidf_(float z) { return fast_rcp(1.0f + fast_exp2(-LOG2E * z)); }
__device__ __forceinline__ float gelu_tanh(float x) {
    const float u = x * (1.0f + 0.044715f * x * x);
    return x * fast_rcp(1.0f + fast_exp2(-2.0f * 0.7978845608028654f * LOG2E * u));
}
__device__ __forceinline__ f32x4 gelu_tanh4(f32x4 x) {
    const f32x4 u = x * (x * x * 0.044715f + 1.0f);
    const f32x4 t = u * (-2.0f * 0.7978845608028654f * LOG2E);
    f32x4 e; e.x = fast_exp2(t.x); e.y = fast_exp2(t.y); e.z = fast_exp2(t.z); e.w = fast_exp2(t.w);
    const f32x4 d = e + 1.0f;
    f32x4 r; r.x = fast_rcp(d.x); r.y = fast_rcp(d.y); r.z = fast_rcp(d.z); r.w = fast_rcp(d.w);
    return x * r;
}
template <int CTRL> __device__ __forceinline__ float dpp_keep(float oldv, float v) {
    return __int_as_float(__builtin_amdgcn_update_dpp(__float_as_int(oldv), __float_as_int(v), CTRL, 0xf, 0xf, false));
}
template <int CTRL> __device__ __forceinline__ float dpp_zf(float v) {
    return __int_as_float(__builtin_amdgcn_update_dpp(0, __float_as_int(v), CTRL, 0xf, 0xf, true));
}
template <int CTRL> __device__ __forceinline__ float dpp_rot(float v) {
    return __int_as_float(__builtin_amdgcn_mov_dpp(__float_as_int(v), CTRL, 0xf, 0xf, true));
}
__device__ __forceinline__ float wave_sum(float v) {
#pragma unroll
    for (int o = 1; o < 64; o <<= 1) v += __shfl_xor(v, o);
    return v;
}

namespace pg8 {
constexpr int BM = 256, BK = 64, HALF = 128, HTB = HALF * BK * 2, STAGE_BYTES = 8 * HTB, NXCD = 8, WGM = 8;
__host__ __device__ __forceinline__ int lds_byte(int r, int c) { const int st = (r >> 4) * 2 + (c >> 5), rr = r & 15, cc = c & 31, ob = rr * 64 + cc * 2; return st * 1024 + (ob ^ (((ob >> 9) & 1) << 5)); }
__host__ __device__ __forceinline__ void stage_rc(int b, int& R, int& C) { const int st = b / 1024, sb = b % 1024, swz = sb ^ (((sb >> 9) & 1) << 5); R = (st >> 1) * 16 + swz / 64; C = (st & 1) * 32 + (swz % 64) / 2; }
__host__ __device__ __forceinline__ int perm32(int rho) { const int n = rho >> 4, i = rho & 15; return 8 * (i >> 2) + 4 * n + (i & 3); }
struct Unit { int pm, pn, half; };
struct Gemm { const bf16_t* A; const bf16_t* Bt; int M, N, K; };
struct StaticOrder {
    int nM, nN, nwg, G, c;
    __host__ __device__ void init(int M_, int N_, int G_, int c_) { nM = M_ / BM; nN = N_ / BM; nwg = nM * nN; G = G_; c = c_; }
    __host__ __device__ bool next(int i, Unit& u) const {
        const long L = (long)i * G + c; if (L >= nwg) return false;
        int wgid = (int)L; { const int q = nwg / NXCD, r = nwg % NXCD, xcd = wgid % NXCD, off = wgid / NXCD; wgid = (xcd < r ? xcd * (q + 1) : r * (q + 1) + (xcd - r) * q) + off; }
        const int nig = WGM * nN, gid = wgid / nig, fm = gid * WGM, gsz = (nM - fm) < WGM ? (nM - fm) : WGM;
        u.pm = fm + ((wgid % nig) % gsz); u.pn = (wgid % nig) / gsz; u.half = 0; return true;
    }
};
struct HalfTailOrder {
    StaticOrder so; int nfull, rem;
    __host__ __device__ void init(int M_, int N_, int G_, int c_) { so.init(M_, N_, G_, c_); nfull = so.nwg / G_; rem = so.nwg - nfull * G_; }
    __host__ __device__ bool next(int i, Unit& u) const {
        if (rem == 0 || 2 * rem > so.G || (rem % 8) != 0 || (so.G % 8) != 0) return so.next(i, u);
        if (i < nfull) return so.next(i, u);
        if (i > nfull || (so.c >> 3) >= 2 * (rem / 8)) return false;
        StaticOrder t = so; t.c = ((so.c >> 3) >> 1) * 8 + (so.c & 7);
        if (!t.next(nfull, u)) return false;
        u.half = 1 + ((so.c >> 3) & 1); return true;
    }
};
struct EpiBf16 {
    static constexpr bool CONV = false;
    static constexpr bool PERM = true;
    static constexpr bool AFTER_DRAIN = false;
    bf16_t* O; int ldc; const float* rowscale;
    __device__ __forceinline__ void operator()(const f32x4 (&acc)[2][2][4][2], const Unit& u, int wr, int wc, int fr, int fq) const {
        const int row0 = u.pm * BM + wr * 64 + fr, col0 = u.pn * BM + wc * 32 + 8 * fq;
        float rsv[2][4];
#pragma unroll
        for (int ai = 0; ai < 2; ++ai)
#pragma unroll
            for (int m = 0; m < 4; ++m) rsv[ai][m] = rowscale[row0 + ai * HALF + m * 16];
#pragma unroll
        for (int ai = 0; ai < 2; ++ai)
#pragma unroll
            for (int m = 0; m < 4; ++m) { const int row = row0 + ai * HALF + m * 16; const float rsc = rsv[ai][m]; bf16_t* rowp = O + (size_t)row * ldc + col0;
#pragma unroll
                for (int bj = 0; bj < 2; ++bj) { const f32x4 v0 = acc[ai][bj][m][0] * rsc, v1 = acc[ai][bj][m][1] * rsc;
                    u32x4 w; w.x = cvt_pk_bf16(v0[0], v0[1]); w.y = cvt_pk_bf16(v0[2], v0[3]); w.z = cvt_pk_bf16(v1[0], v1[1]); w.w = cvt_pk_bf16(v1[2], v1[3]); *(u32x4*)(rowp + bj * HALF) = w; } }
    }
};
struct EpiF32 {
    static constexpr bool CONV = false;
    static constexpr bool PERM = false;
    static constexpr bool AFTER_DRAIN = false;
    float* O; int ldc;
    __device__ __forceinline__ void operator()(const f32x4 (&acc)[2][2][4][2], const Unit& u, int wr, int wc, int fr, int fq) const {
        const int row0 = u.pm * BM + wr * 64 + fr, col0 = u.pn * BM + wc * 32 + 4 * fq;
#pragma unroll
        for (int ai = 0; ai < 2; ++ai)
#pragma unroll
            for (int m = 0; m < 4; ++m) { float* rowp = O + (size_t)(row0 + ai * HALF + m * 16) * ldc + col0;
#pragma unroll
                for (int bj = 0; bj < 2; ++bj)
#pragma unroll
                    for (int n = 0; n < 2; ++n) *(f32x4*)(rowp + bj * HALF + n * 16) = acc[ai][bj][m][n]; }
    }
};
struct EpiConvGate {
    static constexpr bool CONV = true;
    static constexpr bool PERM = true;
    static constexpr bool AFTER_DRAIN = false;
    bf16_t* G; bf16_t* E; const float* cw; const float* cb; const float* rowscale;
    static constexpr int CBUF_OFF = 131072, CBUF_BYTES = 8192;
    __device__ __forceinline__ void prefetch(LAS unsigned char* lds, const Unit& u, int buf, int tid, int wid) const {
        const int rowbase = u.pm * BM + (u.half == 2 ? HALF : 0);
#pragma unroll
        for (int it = 0; it < 4; ++it) {
            const int f = it * 512 + tid;
            const float* gp;
            if (f < 1024) { const int sgm = f >> 7, c = f & 127; const float* sb = (sgm & 3) == 3 ? cb : cw + (sgm & 3) * NUP; gp = sb + (sgm >> 2) * DFF + u.pn * 128 + c; }
            else gp = rowscale + (size_t)rowbase * 4 + (f - 1024);
            __builtin_amdgcn_global_load_lds((const unsigned*)gp, (LAS unsigned*)(lds + CBUF_OFF + buf * CBUF_BYTES + (it * 512 + wid * 64) * 4), 4, 0, 0);
        }
    }
    __device__ __forceinline__ void operator()(const f32x4 (&acc)[2][2][4][2], const Unit& u, int wr, int wc, int fr, int fq, LAS unsigned char* lds, int buf) const {
        const LAS float* CB = (const LAS float*)(lds + CBUF_OFF + buf * CBUF_BYTES);
        u32x2 pk0[2][4];
        float rsv[2][4];
#pragma unroll
        for (int ai = 0; ai < 2; ++ai)
#pragma unroll
            for (int m = 0; m < 4; ++m) { const f32x4 p = *(const LAS f32x4*)(CB + 1024 + 4 * ((u.half ? 0 : ai * HALF) + wr * 64 + 16 * m + fr));
                rsv[ai][m] = __builtin_amdgcn_rsqf(((p.x + p.y) + (p.z + p.w)) * (1.0f / 1024.0f) + RMS_EPS); }
#pragma unroll
        for (int n = 0; n < 2; ++n) {
            const int ch = u.pn * 128 + wc * 32 + 8 * fq + 4 * n;
            const int cc = wc * 32 + 8 * fq + 4 * n;
            const f32x4 wg0 = *(const LAS f32x4*)(CB + cc), wg1 = *(const LAS f32x4*)(CB + 128 + cc), wg2 = *(const LAS f32x4*)(CB + 256 + cc), bg = *(const LAS f32x4*)(CB + 384 + cc);
            const f32x4 wv0 = *(const LAS f32x4*)(CB + 512 + cc), wv1 = *(const LAS f32x4*)(CB + 640 + cc), wv2 = *(const LAS f32x4*)(CB + 768 + cc), bv = *(const LAS f32x4*)(CB + 896 + cc);
#pragma unroll
            for (int ai = 0; ai < 2; ++ai) {
                if (ai == 1 && u.half) continue;
                const int rb = u.pm * BM + (u.half == 2 ? HALF : 0) + ai * HALF + wr * 64, blk = rb >> 6;
                f32x4 pg = (f32x4){0.f, 0.f, 0.f, 0.f}, pv = pg;
#pragma unroll
                for (int m = 0; m < 4; ++m) {
                    const float rsc = rsv[ai][m];
                    const f32x4 g = acc[ai][0][m][n] * rsc, v = acc[ai][1][m][n] * rsc;
                    if (m == 0 && fr < 2) { bf16_t* e = E + ((size_t)(blk * 4 + fr) * 2) * DFF + ch; *(u32x2*)e = (u32x2){cvt_pk_bf16(g[0], g[1]), cvt_pk_bf16(g[2], g[3])}; *(u32x2*)(e + DFF) = (u32x2){cvt_pk_bf16(v[0], v[1]), cvt_pk_bf16(v[2], v[3])}; }
                    if (m == 3 && fr >= 14) { bf16_t* e = E + ((size_t)(blk * 4 + fr - 12) * 2) * DFF + ch; *(u32x2*)e = (u32x2){cvt_pk_bf16(g[0], g[1]), cvt_pk_bf16(g[2], g[3])}; *(u32x2*)(e + DFF) = (u32x2){cvt_pk_bf16(v[0], v[1]), cvt_pk_bf16(v[2], v[3])}; }
                    f32x4 sg1, sg2, sv1, sv2;
#pragma unroll
                    for (int j = 0; j < 4; ++j) { sg1[j] = fr == 15 ? pg[j] : g[j]; sg2[j] = fr >= 14 ? pg[j] : g[j]; sv1[j] = fr == 15 ? pv[j] : v[j]; sv2[j] = fr >= 14 ? pv[j] : v[j]; }
                    f32x4 g1, g2, v1, v2;
#pragma unroll
                    for (int j = 0; j < 4; ++j) { g1[j] = dpp_rot<0x121>(sg1[j]); g2[j] = dpp_rot<0x122>(sg2[j]); v1[j] = dpp_rot<0x121>(sv1[j]); v2[j] = dpp_rot<0x122>(sv2[j]); }
                    const f32x4 cgv = wg0 * g2 + wg1 * g1 + wg2 * g + bg;
                    const f32x4 cvv = wv0 * v2 + wv1 * v1 + wv2 * v + bv;
                    const f32x4 o = gelu_tanh4(cgv) * cvv;
                    u32x2 w; w.x = cvt_pk_bf16(o[0], o[1]); w.y = cvt_pk_bf16(o[2], o[3]);
                    if (n == 0) pk0[ai][m] = w;
                    else *(u32x4*)(G + (size_t)(rb + 16 * m + fr) * DFF + ch - 4) = (u32x4){pk0[ai][m].x, pk0[ai][m].y, w.x, w.y};
                    pg = g; pv = v;
                }
            }
        }
    }
};

struct PanelRms {
    unsigned* xbuf;
    unsigned* cnt;
    __device__ __forceinline__ void run(const f32x4 (&v)[2][2][4][2], const Unit& u, int wr, int wc, int fr, int fq, LAS unsigned char* lds, int wid, int lane) const {
        LAS float* P = (LAS float*)lds;
        LAS float* S = (LAS float*)(lds + 8192);
#pragma unroll
        for (int ai = 0; ai < 2; ++ai)
#pragma unroll
            for (int m = 0; m < 4; ++m) {
                float s = 0.f;
#pragma unroll
                for (int bj = 0; bj < 2; ++bj)
#pragma unroll
                    for (int n = 0; n < 2; ++n) { const f32x4 x = v[ai][bj][m][n]; s += (x[0] * x[0] + x[1] * x[1]) + (x[2] * x[2] + x[3] * x[3]); }
                s += __shfl_xor(s, 16); s += __shfl_xor(s, 32);
                if (fq == 0) P[(ai * HALF + wr * 64 + m * 16 + fr) * 4 + wc] = s;
            }
        asm volatile("s_waitcnt lgkmcnt(0)" ::: "memory"); __builtin_amdgcn_s_barrier(); asm volatile("" ::: "memory");
        const int row = wid * 32 + (lane & 31);
        if (lane < 32) {
            const f32x4 p = *(const LAS f32x4*)(P + row * 4);
            __hip_atomic_store(xbuf + (size_t)(u.pm * BM + row) * 4 + u.pn, __float_as_uint((p.x + p.y) + (p.z + p.w)), __ATOMIC_RELAXED, __HIP_MEMORY_SCOPE_AGENT);
        }
        asm volatile("s_waitcnt vmcnt(0)" ::: "memory");
        if (lane == 0) __hip_atomic_fetch_add(cnt + 64 * u.pm, 1u, __ATOMIC_RELAXED, __HIP_MEMORY_SCOPE_AGENT);
        if (wid == 0) {
            unsigned sp = 0;
            while ((unsigned)__builtin_amdgcn_readfirstlane(__hip_atomic_load(cnt + 64 * u.pm, __ATOMIC_RELAXED, __HIP_MEMORY_SCOPE_AGENT)) < 32u) { __builtin_amdgcn_s_sleep(1); if (++sp > (1u << 22)) break; }
        }
        asm volatile("s_waitcnt vmcnt(0) lgkmcnt(0)" ::: "memory"); __builtin_amdgcn_s_barrier(); asm volatile("" ::: "memory");
        if (lane < 32) {
            const unsigned* slot = xbuf + (size_t)(u.pm * BM + row) * 4; float tot = 0.f;
#pragma unroll
            for (int t = 0; t < 4; ++t) tot += __uint_as_float(__hip_atomic_load(slot + t, __ATOMIC_RELAXED, __HIP_MEMORY_SCOPE_AGENT));
            S[row] = 1.0f / sqrtf(tot * (1.0f / 1024.0f) + RMS_EPS);
        }
        asm volatile("s_waitcnt lgkmcnt(0)" ::: "memory"); __builtin_amdgcn_s_barrier(); asm volatile("" ::: "memory");
    }
};
__device__ __forceinline__ void publish_row_ssq(const f32x4 (&v)[2][2][4][2], const Unit& u, int wr, int wc, int fr, int fq, LAS unsigned char* lds, int wid, int lane, float* pbuf) {
    LAS float* P = (LAS float*)lds;
#pragma unroll
    for (int ai = 0; ai < 2; ++ai)
#pragma unroll
        for (int m = 0; m < 4; ++m) {
            float s = 0.f;
#pragma unroll
            for (int bj = 0; bj < 2; ++bj)
#pragma unroll
                for (int n = 0; n < 2; ++n) { const f32x4 x = v[ai][bj][m][n]; s += (x[0] * x[0] + x[1] * x[1]) + (x[2] * x[2] + x[3] * x[3]); }
            s += __shfl_xor(s, 16); s += __shfl_xor(s, 32);
            if (fq == 0) P[(ai * HALF + wr * 64 + m * 16 + fr) * 4 + wc] = s;
        }
    asm volatile("s_waitcnt lgkmcnt(0)" ::: "memory"); __builtin_amdgcn_s_barrier(); asm volatile("" ::: "memory");
    const int row = wid * 32 + (lane & 31);
    if (lane < 32) { const f32x4 p = *(const LAS f32x4*)(P + row * 4); pbuf[(size_t)(u.pm * BM + row) * 4 + u.pn] = (p.x + p.y) + (p.z + p.w); }
}
struct EpiRmsResRms {
    static constexpr bool CONV = false;
    static constexpr bool PERM = true;
    static constexpr bool AFTER_DRAIN = true;
    const bf16_t* xb; bf16_t* x1b; float* rs2; const float* g1; PanelRms st1, st2;
    __device__ __forceinline__ void fused(f32x4 (&acc)[2][2][4][2], const Unit& u, int wr, int wc, int fr, int fq, LAS unsigned char* lds, int wid, int lane) const {
        const LAS float* S = (const LAS float*)(lds + 8192);
        const int col0 = u.pn * BM + wc * 32 + 8 * fq;
        u32x4 pre[2][4][2];
#pragma unroll
        for (int ai = 0; ai < 2; ++ai)
#pragma unroll
            for (int m = 0; m < 4; ++m) { const size_t off = (size_t)(u.pm * BM + ai * HALF + wr * 64 + m * 16 + fr) * DM + col0;
#pragma unroll
                for (int bj = 0; bj < 2; ++bj) pre[ai][m][bj] = *(const u32x4*)(xb + off + bj * HALF); }
        st1.run(acc, u, wr, wc, fr, fq, lds, wid, lane);
        f32x4 gv[2][2];
#pragma unroll
        for (int bj = 0; bj < 2; ++bj)
#pragma unroll
            for (int n = 0; n < 2; ++n) gv[bj][n] = *(const f32x4*)(g1 + col0 + bj * HALF + 4 * n);
#pragma unroll
        for (int ai = 0; ai < 2; ++ai)
#pragma unroll
            for (int m = 0; m < 4; ++m) { const int r = ai * HALF + wr * 64 + m * 16 + fr; const float rs = S[r]; const size_t off = (size_t)(u.pm * BM + r) * DM + col0;
#pragma unroll
                for (int bj = 0; bj < 2; ++bj) { const u32x4 p = pre[ai][m][bj];
                    const f32x4 x0 = (f32x4){bf_lo(p.x), bf_hi(p.x), bf_lo(p.y), bf_hi(p.y)} + acc[ai][bj][m][0] * rs * gv[bj][0];
                    const f32x4 x1 = (f32x4){bf_lo(p.z), bf_hi(p.z), bf_lo(p.w), bf_hi(p.w)} + acc[ai][bj][m][1] * rs * gv[bj][1];
                    acc[ai][bj][m][0] = x0; acc[ai][bj][m][1] = x1;
                    u32x4 w; w.x = cvt_pk_bf16(x0[0], x0[1]); w.y = cvt_pk_bf16(x0[2], x0[3]); w.z = cvt_pk_bf16(x1[0], x1[1]); w.w = cvt_pk_bf16(x1[2], x1[3]);
                    *(u32x4*)(x1b + off + bj * HALF) = w; }
                if (m & 1) asm volatile("" ::: "memory"); }
        publish_row_ssq(acc, u, wr, wc, fr, fq, lds, wid, lane, rs2);
    }
};
struct EpiRmsRes {
    static constexpr bool CONV = false;
    static constexpr bool PERM = true;
    static constexpr bool AFTER_DRAIN = true;
    const bf16_t* x1b; float* out; const float* g; PanelRms st;
    __device__ __forceinline__ void fused(f32x4 (&acc)[2][2][4][2], const Unit& u, int wr, int wc, int fr, int fq, LAS unsigned char* lds, int wid, int lane) const {
        const LAS float* S = (const LAS float*)(lds + 8192);
        const int col0 = u.pn * BM + wc * 32 + 8 * fq;
        u32x4 pre[2][4][2];
#pragma unroll
        for (int ai = 0; ai < 2; ++ai)
#pragma unroll
            for (int m = 0; m < 4; ++m) { const size_t off = (size_t)(u.pm * BM + ai * HALF + wr * 64 + m * 16 + fr) * DM + col0;
#pragma unroll
                for (int bj = 0; bj < 2; ++bj) pre[ai][m][bj] = *(const u32x4*)(x1b + off + bj * HALF); }
        st.run(acc, u, wr, wc, fr, fq, lds, wid, lane);
        f32x4 gv[2][2];
#pragma unroll
        for (int bj = 0; bj < 2; ++bj)
#pragma unroll
            for (int n = 0; n < 2; ++n) gv[bj][n] = *(const f32x4*)(g + col0 + bj * HALF + 4 * n);
#pragma unroll
        for (int ai = 0; ai < 2; ++ai)
#pragma unroll
            for (int m = 0; m < 4; ++m) { const int r = ai * HALF + wr * 64 + m * 16 + fr; const float rs = S[r]; const size_t off = (size_t)(u.pm * BM + r) * DM + col0;
#pragma unroll
                for (int bj = 0; bj < 2; ++bj) { const u32x4 p = pre[ai][m][bj];
                    *(f32x4*)(out + off + bj * HALF) = (f32x4){bf_lo(p.x), bf_hi(p.x), bf_lo(p.y), bf_hi(p.y)} + acc[ai][bj][m][0] * rs * gv[bj][0];
                    *(f32x4*)(out + off + bj * HALF + 4) = (f32x4){bf_lo(p.z), bf_hi(p.z), bf_lo(p.w), bf_hi(p.w)} + acc[ai][bj][m][1] * rs * gv[bj][1]; }
                if (m & 1) asm volatile("" ::: "memory"); }
    }
};

template <class Epi, class Sched, bool ALIGN_EPI, bool SP2>
__device__ __forceinline__ void gemm_phase(LAS unsigned char* lds, const Gemm g, const Sched& S, const Epi& E) {
    const int tid = threadIdx.x, wid = __builtin_amdgcn_readfirstlane(tid >> 6), lane = tid & 63, wr = wid >> 2, wc = wid & 3, fr = lane & 15, fq = lane >> 4;
    const int K = g.K, nt = K / BK;
    unsigned voffA[2], voffB[2];
#pragma unroll
    for (int i = 0; i < 2; ++i) { int R, C; stage_rc(tid * 16 + i * 8192, R, C); const int Rb = Epi::PERM ? ((R & ~31) + perm32(R & 31)) : R; voffA[i] = (unsigned)(R * K + C) * 2u; voffB[i] = (unsigned)(Rb * K + C) * 2u; }
    const size_t kstep = (size_t)(BK * 2);
    const size_t hstep = (size_t)HALF * K * 2;
    const size_t tstep = 2 * hstep;
    const unsigned ldsw = (unsigned)wid * 1024u;
    const int aoff = lds_byte(wr * 64 + fr, fq * 8), boff = lds_byte(wc * 32 + fr, fq * 8);
#define PG8_SA(b, h) (((b) * 2 + (h)) * HTB)
#define PG8_SB(b, h) ((4 + (b) * 2 + (h)) * HTB)
#define PG8_STAGE(bufoff, gbase, voff) do { _Pragma("unroll") for (int _i = 0; _i < 2; ++_i) \
        __builtin_amdgcn_global_load_lds((const unsigned*)((const char*)(gbase) + (voff)[_i]), (LAS unsigned*)(lds + (bufoff) + ldsw + _i * 8192), 16, 0, 0); } while (0)
#define PG8_LDA(dst, b, h) do { _Pragma("unroll") for (int m = 0; m < 4; ++m) _Pragma("unroll") for (int k = 0; k < 2; ++k) dst[m][k] = *(const LAS bf16x8*)(lds + PG8_SA(b, h) + aoff + m * 2048 + k * 1024); } while (0)
#define PG8_LDB(dst, b, h) do { _Pragma("unroll") for (int n = 0; n < 2; ++n) _Pragma("unroll") for (int k = 0; k < 2; ++k) dst[n][k] = *(const LAS bf16x8*)(lds + PG8_SB(b, h) + boff + n * 2048 + k * 1024); } while (0)
#define PG8_MMA(ai, bj, At, Bt) do { __builtin_amdgcn_s_setprio(1); _Pragma("unroll") for (int m = 0; m < 4; ++m) _Pragma("unroll") for (int n = 0; n < 2; ++n) _Pragma("unroll") for (int k = 0; k < 2; ++k) \
        acc[ai][bj][m][n] = __builtin_amdgcn_mfma_f32_16x16x32_bf16(Bt[n][k], At[m][k], acc[ai][bj][m][n], 0, 0, 0); __builtin_amdgcn_s_setprio(0); } while (0)
#define PG8_WAIT_V(n) asm volatile("s_waitcnt vmcnt(" #n ")" ::: "memory")
#define PG8_WAIT_L(n) asm volatile("s_waitcnt lgkmcnt(" #n ")" ::: "memory")
#define PG8_BAR __builtin_amdgcn_s_barrier()
#define PG8_SCHED __builtin_amdgcn_sched_barrier(0)
    Unit cur, nxt; int ui = 0;
    if (!S.next(0, cur)) return;
    f32x4 acc[2][2][4][2];
#pragma unroll
    for (int a = 0; a < 2; ++a)
#pragma unroll
        for (int b = 0; b < 2; ++b)
#pragma unroll
            for (int m = 0; m < 4; ++m)
#pragma unroll
                for (int n = 0; n < 2; ++n) acc[a][b][m][n] = (f32x4){0.f, 0.f, 0.f, 0.f};
    bf16x8 At[4][2], B0[2][2], B1[2][2];
    const char* cA = (const char*)g.A + (size_t)cur.pm * tstep + (cur.half == 2 ? hstep : 0); const char* cB = (const char*)g.Bt + (size_t)cur.pn * tstep;
    if constexpr (Epi::CONV) E.prefetch(lds, cur, 0, tid, wid);
    if constexpr (SP2) {
        PG8_STAGE(PG8_SB(0, 0), cB, voffB); PG8_STAGE(PG8_SB(0, 1), cB + hstep, voffB); PG8_STAGE(PG8_SA(0, 0), cA, voffA); PG8_STAGE(PG8_SA(0, 1), cA + hstep, voffA);
        if (wr == 1) PG8_BAR;
        PG8_WAIT_V(2); PG8_BAR;
        PG8_STAGE(PG8_SB(1, 0), cB + kstep, voffB); PG8_STAGE(PG8_SA(1, 0), cA + kstep, voffA); PG8_STAGE(PG8_SB(1, 1), cB + hstep + kstep, voffB);
        PG8_WAIT_V(6); PG8_BAR;
    } else {
        PG8_STAGE(PG8_SB(0, 0), cB, voffB); PG8_STAGE(PG8_SA(0, 0), cA, voffA); PG8_STAGE(PG8_SB(0, 1), cB + hstep, voffB); PG8_STAGE(PG8_SA(0, 1), cA + hstep, voffA);
        if (wr == 1) PG8_BAR;
        PG8_WAIT_V(4); PG8_BAR;
        PG8_STAGE(PG8_SB(1, 0), cB + kstep, voffB); PG8_STAGE(PG8_SA(1, 0), cA + kstep, voffA); PG8_STAGE(PG8_SB(1, 1), cB + hstep + kstep, voffB);
        PG8_WAIT_V(6); PG8_BAR;
    }
    for (;;) {
        const bool has_next = S.next(ui + 1, nxt);
        const char* nA = has_next ? (const char*)g.A + (size_t)nxt.pm * tstep + (nxt.half == 2 ? hstep : 0) : cA; const char* nB = has_next ? (const char*)g.Bt + (size_t)nxt.pn * tstep : cB;
        for (int t = 0; t < nt; t += 2) {
            const bool last = (t == nt - 2);
            const char* a1 = cA + (size_t)(t + 1) * kstep;
            const char* a2 = last ? nA : cA + (size_t)(t + 2) * kstep; const char* b2 = last ? nB : cB + (size_t)(t + 2) * kstep;
            const char* a3 = a2 + kstep; const char* b3 = b2 + kstep;
            if constexpr (Epi::CONV) { if (last && has_next) E.prefetch(lds, nxt, (ui + 1) & 1, tid, wid); }
            if constexpr (SP2) {
            PG8_LDB(B0, 0, 0); PG8_LDB(B1, 0, 1); PG8_SCHED; PG8_LDA(At, 0, 0); PG8_STAGE(PG8_SA(1, 1), a1 + hstep, voffA);
            PG8_WAIT_V(8); PG8_WAIT_L(0); PG8_BAR; PG8_MMA(0, 0, At, B0); PG8_MMA(0, 1, At, B1); PG8_BAR; PG8_SCHED;
            if (!cur.half) PG8_LDA(At, 0, 1); PG8_STAGE(PG8_SB(0, 0), b2, voffB); PG8_STAGE(PG8_SB(0, 1), b2 + hstep, voffB); PG8_STAGE(PG8_SA(0, 0), a2, voffA);
            PG8_WAIT_V(8); PG8_WAIT_L(0); PG8_BAR; if (!cur.half) { PG8_MMA(1, 0, At, B0); PG8_MMA(1, 1, At, B1); } PG8_BAR; PG8_SCHED;
            PG8_LDB(B0, 1, 0); PG8_LDB(B1, 1, 1); PG8_SCHED; PG8_LDA(At, 1, 0); PG8_STAGE(PG8_SA(0, 1), a2 + hstep, voffA);
            PG8_WAIT_V(8); PG8_WAIT_L(0); PG8_BAR; PG8_MMA(0, 0, At, B0); PG8_MMA(0, 1, At, B1); PG8_BAR; PG8_SCHED;
            if (!cur.half) PG8_LDA(At, 1, 1); PG8_STAGE(PG8_SB(1, 0), b3, voffB); PG8_STAGE(PG8_SB(1, 1), b3 + hstep, voffB); PG8_STAGE(PG8_SA(1, 0), a3, voffA);
            PG8_WAIT_V(8); PG8_WAIT_L(0); PG8_BAR; if (!cur.half) { PG8_MMA(1, 0, At, B0); PG8_MMA(1, 1, At, B1); } PG8_BAR; PG8_SCHED;
            } else {
            PG8_LDB(B0, 0, 0); PG8_SCHED; PG8_LDA(At, 0, 0); PG8_STAGE(PG8_SA(1, 1), a1 + hstep, voffA);
            PG8_WAIT_L(8); PG8_BAR; PG8_WAIT_L(0); PG8_MMA(0, 0, At, B0); PG8_BAR; PG8_SCHED;
            PG8_LDB(B1, 0, 1); PG8_STAGE(PG8_SB(0, 0), b2, voffB);
            PG8_BAR; PG8_WAIT_L(0); PG8_MMA(0, 1, At, B1); PG8_BAR;
            PG8_LDA(At, 0, 1); PG8_STAGE(PG8_SA(0, 0), a2, voffA);
            PG8_BAR; PG8_WAIT_L(0); PG8_MMA(1, 0, At, B0); PG8_BAR; PG8_SCHED;
            PG8_STAGE(PG8_SB(0, 1), b2 + hstep, voffB);
            PG8_WAIT_V(6); PG8_BAR; PG8_MMA(1, 1, At, B1); PG8_BAR;
            PG8_LDB(B0, 1, 0); PG8_SCHED; PG8_LDA(At, 1, 0); PG8_STAGE(PG8_SA(0, 1), a2 + hstep, voffA);
            PG8_WAIT_L(8); PG8_BAR; PG8_WAIT_L(0); PG8_MMA(0, 0, At, B0); PG8_BAR; PG8_SCHED;
            PG8_LDB(B1, 1, 1); PG8_STAGE(PG8_SB(1, 0), b3, voffB);
            PG8_BAR; PG8_WAIT_L(0); PG8_MMA(0, 1, At, B1); PG8_BAR;
            PG8_LDA(At, 1, 1); PG8_STAGE(PG8_SA(1, 0), a3, voffA);
            PG8_BAR; PG8_WAIT_L(0); PG8_MMA(1, 0, At, B0); PG8_BAR; PG8_SCHED;
            PG8_STAGE(PG8_SB(1, 1), b3 + hstep, voffB);
            PG8_WAIT_V(6); PG8_BAR; PG8_MMA(1, 1, At, B1); PG8_BAR;
            }
        }
        if constexpr (ALIGN_EPI) { if (wr == 0) PG8_BAR; }
        if constexpr (Epi::CONV) E(acc, cur, wr, wc, fr, fq, lds, ui & 1);
        else if constexpr (!Epi::AFTER_DRAIN) E(acc, cur, wr, wc, fr, fq);
        if (!has_next) break;
#pragma unroll
        for (int a = 0; a < 2; ++a)
#pragma unroll
            for (int b = 0; b < 2; ++b)
#pragma unroll
                for (int m = 0; m < 4; ++m)
#pragma unroll
                    for (int n = 0; n < 2; ++n) acc[a][b][m][n] = (f32x4){0.f, 0.f, 0.f, 0.f};
        cur = nxt; cA = nA; cB = nB; ++ui;
        if constexpr (ALIGN_EPI) { if (wr == 1) PG8_BAR; }
    }
    PG8_WAIT_V(0);
    if constexpr (!ALIGN_EPI) { if (wr == 0) PG8_BAR; }
    PG8_BAR;
    if constexpr (Epi::AFTER_DRAIN) E.fused(acc, cur, wr, wc, fr, fq, lds, wid, lane);
#undef PG8_SA
#undef PG8_SB
#undef PG8_STAGE
#undef PG8_LDA
#undef PG8_LDB
#undef PG8_MMA
#undef PG8_WAIT_V
#undef PG8_WAIT_L
#undef PG8_BAR
#undef PG8_SCHED
}
}

template <bool PERMUP, bool WTHRU = false>
__device__ __forceinline__ void p0_transpose_item(const float* W, int K, int N, bf16_t* WT, LAS float* scr, int item, int lane, const float* kgain = nullptr) {
    const int nblk = N / 64, kb = item / nblk, nb = item % nblk, k0 = 64 * kb, n0 = 64 * nb;
    int d0 = n0;
    if (PERMUP) d0 = (n0 < DFF) ? (256 * (n0 / 128) + (n0 % 128)) : (256 * ((n0 - DFF) / 128) + 128 + ((n0 - DFF) % 128));
#pragma unroll 16
    for (int i = 0; i < 64; ++i) scr[i * 65 + lane] = W[(size_t)(k0 + i) * N + n0 + lane];
    asm volatile("s_waitcnt lgkmcnt(0)" ::: "memory");
    const int c = lane & 7;
    f32x4 ga = (f32x4){1.f, 1.f, 1.f, 1.f}, gb = ga;
    if (kgain) { ga = *(const f32x4*)(kgain + k0 + 8 * c); gb = *(const f32x4*)(kgain + k0 + 8 * c + 4); }
#pragma unroll
    for (int j = 0; j < 8; ++j) { const int n = (lane >> 3) + 8 * j; const LAS float* s = scr + (8 * c) * 65 + n;
        u32x4 o; o.x = cvt_pk_bf16(s[0 * 65] * ga.x, s[1 * 65] * ga.y); o.y = cvt_pk_bf16(s[2 * 65] * ga.z, s[3 * 65] * ga.w); o.z = cvt_pk_bf16(s[4 * 65] * gb.x, s[5 * 65] * gb.y); o.w = cvt_pk_bf16(s[6 * 65] * gb.z, s[7 * 65] * gb.w);
        bf16_t* dst = WT + (size_t)(d0 + n) * K + k0 + 8 * c;
        if (WTHRU) asm volatile("global_store_dwordx4 %0, %1, off sc1\n\ts_nop 1" :: "v"(dst), "v"(o) : "memory");
        else *(u32x4*)dst = o; }
    asm volatile("s_waitcnt lgkmcnt(0)" ::: "memory");
}
__device__ __forceinline__ void row_to_bf16_rs(const float* xrow, bf16_t* orow, float* rs_out, int lane) {
    const f32x4* xr = (const f32x4*)xrow + lane;
    f32x4 v[4]; float s = 0.f;
#pragma unroll
    for (int j = 0; j < 4; ++j) { v[j] = xr[64 * j]; s += (v[j].x * v[j].x + v[j].y * v[j].y) + (v[j].z * v[j].z + v[j].w * v[j].w); }
    const float rs = 1.0f / sqrtf(wave_sum(s) * (1.f / DM) + RMS_EPS);
    u32x2* o8 = (u32x2*)orow + lane;
#pragma unroll
    for (int j = 0; j < 4; ++j) { u32x2 w; w.x = cvt_pk_bf16(v[j].x, v[j].y); w.y = cvt_pk_bf16(v[j].z, v[j].w); o8[64 * j] = w; }
    if (lane == 0) *rs_out = rs;
}

constexpr int KSTR = 136, VSTR = 216, KROWS = 208;
constexpr int ATT_VT_OFF = KROWS * KSTR * 2;
constexpr int ATT_SS_OFF = ATT_VT_OFF + 128 * VSTR * 2;
__device__ __forceinline__ void attn_unit(LAS unsigned char* lds, const bf16_t* PROJ, bf16_t* MERGED, const float* sinks, const float* g_attn, int u, int tid, int wid, int lane) {
    const int b = u >> 5, qb = u & 31;
    const int kb0 = 64 * qb - 144;
    LAS bf16_t* Ks = (LAS bf16_t*)lds;
    LAS bf16_t* Vt = (LAS bf16_t*)(lds + ATT_VT_OFF);
    LAS float* SS = (LAS float*)(lds + ATT_SS_OFF);
    const bf16_t* base = PROJ + (size_t)b * SEQ * INW;
    for (int task = tid; task < KROWS * 16; task += 512) {
        const int kr = task >> 4, cc = task & 15, tok = kb0 + kr;
        u32x4 v = *(const u32x4*)(base + (size_t)(tok < 0 ? 0 : tok) * INW + KOFF + 8 * cc);
        if (tok < 0) v = (u32x4){0u, 0u, 0u, 0u};
        *(LAS u32x4*)(Ks + kr * KSTR + 8 * cc) = v;
    }
    for (int task = tid; task < (KROWS / 2) * 16; task += 512) {
        const int kp = task % (KROWS / 2), dc = task / (KROWS / 2), tok = kb0 + 2 * kp;
        const int tokc = tok < 0 ? 0 : tok;
        u32x4 a0 = *(const u32x4*)(base + (size_t)tokc * INW + VOFF + 8 * dc), a1 = *(const u32x4*)(base + (size_t)(tokc + 1) * INW + VOFF + 8 * dc);
        if (tok < 0) { a0 = (u32x4){0u, 0u, 0u, 0u}; a1 = a0; }
#pragma unroll
        for (int e = 0; e < 8; ++e) {
            const unsigned w0 = a0[e >> 1], w1 = a1[e >> 1];
            const unsigned lo = (e & 1) ? (w0 >> 16) : (w0 & 0xffffu), hi = (e & 1) ? (w1 & 0xffff0000u) : (w1 << 16);
            *(LAS unsigned*)(Vt + (8 * dc + e) * VSTR + 2 * kp) = lo | hi;
        }
    }
    __syncthreads();
    const int h = wid, kvh = h >> 2, qq = lane & 15, g = lane >> 4;
    const float slope2 = fast_exp2(-(float)(h + 1)) * LOG2E, sink2 = sinks[h] * LOG2E;
    f32x4 O[4][4];
#pragma unroll
    for (int i = 0; i < 4; ++i) {
        const int tq = 64 * qb + 16 * i + qq;
        const bf16_t* qp = base + (size_t)tq * INW + h * 64 + 8 * g;
        const bf16x8 qf0 = *(const bf16x8*)qp, qf1 = *(const bf16x8*)(qp + 32);
        f32x4 S[9];
#pragma unroll
        for (int jb = 0; jb < 9; ++jb) {
            const LAS bf16_t* kp = Ks + (16 * i + 16 + 16 * jb + qq) * KSTR + kvh * 64 + 8 * g;
            const bf16x8 k0 = *(const LAS bf16x8*)kp, k1 = *(const LAS bf16x8*)(kp + 32);
            f32x4 s = (f32x4){0.f, 0.f, 0.f, 0.f};
            s = __builtin_amdgcn_mfma_f32_16x16x32_bf16(k0, qf0, s, 0, 0, 0);
            s = __builtin_amdgcn_mfma_f32_16x16x32_bf16(k1, qf1, s, 0, 0, 0);
            S[jb] = s;
        }
        float mx = sink2;
#pragma unroll
        for (int jb = 0; jb < 9; ++jb)
#pragma unroll
            for (int r = 0; r < 4; ++r) {
                const int kk = 4 * g + r, dist = 128 - 16 * jb + qq - kk, ktok = 64 * qb + 16 * i - 128 + 16 * jb + kk;
                const bool valid = (dist >= 0) && (dist < 128) && (ktok >= 0);
                float l = S[jb][r] * (0.125f * LOG2E) - slope2 * (float)dist;
                l = valid ? l : -INFINITY;
                S[jb][r] = l; mx = fmaxf(mx, l);
            }
        mx = fmaxf(mx, __shfl_xor(mx, 16)); mx = fmaxf(mx, __shfl_xor(mx, 32));
        float den = 0.f;
#pragma unroll
        for (int jb = 0; jb < 9; ++jb)
#pragma unroll
            for (int r = 0; r < 4; ++r) { const float p = fast_exp2(S[jb][r] - mx); den += p; S[jb][r] = p; }
        den += __shfl_xor(den, 16); den += __shfl_xor(den, 32);
        den += fast_exp2(sink2 - mx);
        const float inv = fast_rcp(den);
#pragma unroll
        for (int db = 0; db < 4; ++db) O[i][db] = (f32x4){0.f, 0.f, 0.f, 0.f};
#pragma unroll
        for (int ks2 = 0; ks2 < 5; ++ks2) {
            u32x4 pw;
            if (ks2 == 0) { pw.x = 0u; pw.y = 0u; } else { pw.x = cvt_pk_bf16(S[2 * ks2 - 1][0], S[2 * ks2 - 1][1]); pw.y = cvt_pk_bf16(S[2 * ks2 - 1][2], S[2 * ks2 - 1][3]); }
            pw.z = cvt_pk_bf16(S[2 * ks2][0], S[2 * ks2][1]); pw.w = cvt_pk_bf16(S[2 * ks2][2], S[2 * ks2][3]);
            const bf16x8 pf = __builtin_bit_cast(bf16x8, pw);
#pragma unroll
            for (int db = 0; db < 4; ++db) {
                const LAS bf16_t* vp = Vt + (kvh * 64 + 16 * (qq >> 2) + 4 * db + (qq & 3)) * VSTR + 16 * i + 32 * ks2 + 4 * g;
                const u32x2 lo = *(const LAS u32x2*)vp, hi = *(const LAS u32x2*)(vp + 16);
                const u32x4 vw = (u32x4){lo.x, lo.y, hi.x, hi.y};
                O[i][db] = __builtin_amdgcn_mfma_f32_16x16x32_bf16(__builtin_bit_cast(bf16x8, vw), pf, O[i][db], 0, 0, 0);
            }
        }
        float ssq = 0.f;
#pragma unroll
        for (int db = 0; db < 4; ++db) { O[i][db] = O[i][db] * inv; const f32x4 o = O[i][db]; ssq += (o.x * o.x + o.y * o.y) + (o.z * o.z + o.w * o.w); }
        ssq += __shfl_xor(ssq, 16); ssq += __shfl_xor(ssq, 32);
        if (g == 0) SS[(16 * i + qq) * 8 + h] = ssq;
    }
    __syncthreads();
#pragma unroll
    for (int i = 0; i < 4; ++i) {
        const f32x4 s0 = *(const LAS f32x4*)(SS + (16 * i + qq) * 8), s1 = *(const LAS f32x4*)(SS + (16 * i + qq) * 8 + 4);
        const float tot = (s0.x + s0.y) + (s0.z + s0.w) + (s1.x + s1.y) + (s1.z + s1.w);
        const float rs = __builtin_amdgcn_rsqf(tot * (1.f / 512.f) + RMS_EPS);
        bf16_t* orow = MERGED + (size_t)(b * SEQ + 64 * qb + 16 * i + qq) * DM + h * 64 + 16 * g;
        unsigned pk[8];
#pragma unroll
        for (int db = 0; db < 4; ++db) {
            const f32x4 gg = *(const f32x4*)(g_attn + h * 64 + 16 * g + 4 * db); const f32x4 o = O[i][db];
            pk[2 * db] = cvt_pk_bf16(o.x * rs * gg.x, o.y * rs * gg.y); pk[2 * db + 1] = cvt_pk_bf16(o.z * rs * gg.z, o.w * rs * gg.w);
        }
        *(u32x4*)orow = (u32x4){pk[0], pk[1], pk[2], pk[3]}; *(u32x4*)(orow + 8) = (u32x4){pk[4], pk[5], pk[6], pk[7]};
    }
    __syncthreads();
}

__device__ __forceinline__ void lru_unit(LAS unsigned char* lds, const bf16_t* PROJ, const bf16_t* WaT, const bf16_t* WxT, const float* convw, const float* convb, const float* ba, const float* bx, const float* sp,
                                         float* SUMM, unsigned* FLAG, const float* g_lru, bf16_t* MERGED, bool xl, int u, int tid, int wid, int lane) {
    const int b = u >> 5, c = u & 31, hd = wid, fr = lane & 15, g = lane >> 4;
    constexpr int HSTR = 520;
    LAS bf16_t* HLs = (LAS bf16_t*)lds; LAS bf16_t* ACs = (LAS bf16_t*)(lds + 64 * HSTR * 2);
    LAS float* C = (LAS float*)(lds + 2 * 64 * HSTR * 2);
    LAS float* Hs = C + 4096;
    C[tid] = convw[tid]; C[512 + tid] = convw[512 + tid]; C[1024 + tid] = convw[1024 + tid]; C[1536 + tid] = convw[1536 + tid];
    C[2048 + tid] = convb[tid]; C[2560 + tid] = ba[tid]; C[3072 + tid] = bx[tid]; C[3584 + tid] = sp[tid];
    bf16x8 wa[4][2], wx[4][2];
#pragma unroll
    for (int ob = 0; ob < 4; ++ob)
#pragma unroll
        for (int ks = 0; ks < 2; ++ks) {
            const size_t off = (size_t)(hd * 64 + 16 * (fr >> 2) + 4 * ob + (fr & 3)) * 64 + 16 * g + 8 * ks;
            wa[ob][ks] = *(const bf16x8*)(WaT + off); wx[ob][ks] = *(const bf16x8*)(WxT + off);
        }
    __syncthreads();
    f32x4 cH[4], cA[4];
#pragma unroll
    for (int ob = 0; ob < 4; ++ob) { cH[ob] = (f32x4){0.f, 0.f, 0.f, 0.f}; cA[ob] = (f32x4){1.f, 1.f, 1.f, 1.f}; }
    const int chb = hd * 64 + 16 * g;
    const bf16_t* lxb = PROJ + (size_t)b * SEQ * INW + LXOFF + chb;
#pragma unroll 1
    for (int tb = 0; tb < 4; ++tb) {
        const int t = 64 * c + 16 * tb + fr;
        u32x4 raw[4][2];
#pragma unroll
        for (int k = 0; k < 4; ++k) {
            const int tt = t - 3 + k, ttc = tt < 0 ? 0 : tt;
            raw[k][0] = *(const u32x4*)(lxb + (size_t)ttc * INW); raw[k][1] = *(const u32x4*)(lxb + (size_t)ttc * INW + 8);
            if (tt < 0) { raw[k][0] = (u32x4){0u, 0u, 0u, 0u}; raw[k][1] = raw[k][0]; }
        }
        float xc[16];
#pragma unroll
        for (int q = 0; q < 4; ++q) {
            f32x4 a = *(const LAS f32x4*)(C + 2048 + chb + 4 * q);
#pragma unroll
            for (int k = 0; k < 4; ++k) {
                const f32x4 w = *(const LAS f32x4*)(C + k * 512 + chb + 4 * q);
                const unsigned r0 = raw[k][q >> 1][2 * (q & 1)], r1 = raw[k][q >> 1][2 * (q & 1) + 1];
                a = a + w * (f32x4){bf_lo(r0), bf_hi(r0), bf_lo(r1), bf_hi(r1)};
            }
            xc[4 * q] = a.x; xc[4 * q + 1] = a.y; xc[4 * q + 2] = a.z; xc[4 * q + 3] = a.w;
        }
        bf16x8 xf[2];
#pragma unroll
        for (int ks = 0; ks < 2; ++ks) {
            u32x4 w; w.x = cvt_pk_bf16(xc[8 * ks], xc[8 * ks + 1]); w.y = cvt_pk_bf16(xc[8 * ks + 2], xc[8 * ks + 3]);
            w.z = cvt_pk_bf16(xc[8 * ks + 4], xc[8 * ks + 5]); w.w = cvt_pk_bf16(xc[8 * ks + 6], xc[8 * ks + 7]);
            xf[ks] = __builtin_bit_cast(bf16x8, w);
        }
        const size_t row = (size_t)b * SEQ + t;
#pragma unroll
        for (int ob = 0; ob < 4; ++ob) {
            f32x4 R = (f32x4){0.f, 0.f, 0.f, 0.f}, I = R;
            R = __builtin_amdgcn_mfma_f32_16x16x32_bf16(wa[ob][0], xf[0], R, 0, 0, 0); R = __builtin_amdgcn_mfma_f32_16x16x32_bf16(wa[ob][1], xf[1], R, 0, 0, 0);
            I = __builtin_amdgcn_mfma_f32_16x16x32_bf16(wx[ob][0], xf[0], I, 0, 0, 0); I = __builtin_amdgcn_mfma_f32_16x16x32_bf16(wx[ob][1], xf[1], I, 0, 0, 0);
            const f32x4 bav = *(const LAS f32x4*)(C + 2560 + chb + 4 * ob), bxv = *(const LAS f32x4*)(C + 3072 + chb + 4 * ob), spv = *(const LAS f32x4*)(C + 3584 + chb + 4 * ob);
            float hl[4], ac[4];
            f32x4 av4, uv4;
            {
                const f32x4 tr = (R + bav) * (-LOG2E), ti = (I + bxv) * (-LOG2E);
                f32x4 er, ei; er.x = fast_exp2(tr.x); er.y = fast_exp2(tr.y); er.z = fast_exp2(tr.z); er.w = fast_exp2(tr.w);
                ei.x = fast_exp2(ti.x); ei.y = fast_exp2(ti.y); ei.z = fast_exp2(ti.z); ei.w = fast_exp2(ti.w);
                const f32x4 dr = er + 1.0f, di = ei + 1.0f;
                f32x4 rg, ig; rg.x = fast_rcp(dr.x); rg.y = fast_rcp(dr.y); rg.z = fast_rcp(dr.z); rg.w = fast_rcp(dr.w);
                ig.x = fast_rcp(di.x); ig.y = fast_rcp(di.y); ig.z = fast_rcp(di.z); ig.w = fast_rcp(di.w);
                const f32x4 la2 = rg * spv * (-8.0f * LOG2E);
                f32x4 a4; a4.x = fast_exp2(la2.x); a4.y = fast_exp2(la2.y); a4.z = fast_exp2(la2.z); a4.w = fast_exp2(la2.w);
                f32x4 om = 1.0f - a4 * a4;
                om.x = fmaxf(om.x, 0.f); om.y = fmaxf(om.y, 0.f); om.z = fmaxf(om.z, 0.f); om.w = fmaxf(om.w, 0.f);
                f32x4 sq; sq.x = __builtin_amdgcn_sqrtf(om.x); sq.y = __builtin_amdgcn_sqrtf(om.y); sq.z = __builtin_amdgcn_sqrtf(om.z); sq.w = __builtin_amdgcn_sqrtf(om.w);
                const f32x4 xv = (f32x4){xc[4 * ob], xc[4 * ob + 1], xc[4 * ob + 2], xc[4 * ob + 3]};
                av4 = a4; uv4 = sq * ig * xv;
            }
            float av[4] = {av4.x, av4.y, av4.z, av4.w}, uv[4] = {uv4.x, uv4.y, uv4.z, uv4.w};
#define LRU_SCAN_STEP(SH) asm volatile("s_nop 1\n\t" \
                "v_fmac_f32_dpp %0, %0, %4 row_shr:" #SH " row_mask:0xf bank_mask:0xf\n\tv_fmac_f32_dpp %1, %1, %5 row_shr:" #SH " row_mask:0xf bank_mask:0xf\n\t" \
                "v_fmac_f32_dpp %2, %2, %6 row_shr:" #SH " row_mask:0xf bank_mask:0xf\n\tv_fmac_f32_dpp %3, %3, %7 row_shr:" #SH " row_mask:0xf bank_mask:0xf\n\t" \
                "v_mul_f32_dpp %4, %4, %4 row_shr:" #SH " row_mask:0xf bank_mask:0xf\n\tv_mul_f32_dpp %5, %5, %5 row_shr:" #SH " row_mask:0xf bank_mask:0xf\n\t" \
                "v_mul_f32_dpp %6, %6, %6 row_shr:" #SH " row_mask:0xf bank_mask:0xf\n\tv_mul_f32_dpp %7, %7, %7 row_shr:" #SH " row_mask:0xf bank_mask:0xf\n\ts_nop 1" \
                : "+v"(uv[0]), "+v"(uv[1]), "+v"(uv[2]), "+v"(uv[3]), "+v"(av[0]), "+v"(av[1]), "+v"(av[2]), "+v"(av[3]))
            LRU_SCAN_STEP(1); LRU_SCAN_STEP(2); LRU_SCAN_STEP(4); LRU_SCAN_STEP(8);
#undef LRU_SCAN_STEP
#pragma unroll
            for (int r = 0; r < 4; ++r) {
                hl[r] = uv[r] + av[r] * cH[ob][r]; ac[r] = av[r] * cA[ob][r];
                cH[ob][r] = __shfl(hl[r], (lane & 48) | 15); cA[ob][r] = __shfl(ac[r], (lane & 48) | 15);
            }
            { LAS bf16_t* hr = HLs + (16 * tb + fr) * HSTR + chb + 4 * ob; LAS bf16_t* ar = ACs + (16 * tb + fr) * HSTR + chb + 4 * ob;
              *(LAS u32x2*)hr = (u32x2){cvt_pk_bf16(hl[0], hl[1]), cvt_pk_bf16(hl[2], hl[3])}; *(LAS u32x2*)ar = (u32x2){cvt_pk_bf16(ac[0], ac[1]), cvt_pk_bf16(ac[2], ac[3])}; }
        }
    }
    const int lane_t = (int)__builtin_amdgcn_mbcnt_hi(~0u, __builtin_amdgcn_mbcnt_lo(~0u, 0u));
    const int tid_t = wid * 64 + lane_t, fr_t = lane_t & 15, chb_t = hd * 64 + 16 * (lane_t >> 4);
    if (fr_t == 0) {
        unsigned* sa = (unsigned*)(SUMM + ((size_t)(b * 32 + c) * 2 + 0) * 512 + chb_t); unsigned* sh = sa + 512;
        if (xl) {
#pragma unroll
            for (int ob = 0; ob < 4; ++ob) { *(f32x4*)(sa + 4 * ob) = cA[ob]; *(f32x4*)(sh + 4 * ob) = cH[ob]; }
        } else {
#pragma unroll
        for (int ob = 0; ob < 4; ++ob)
#pragma unroll
            for (int r = 0; r < 4; ++r) {
                __hip_atomic_store(sa + 4 * ob + r, __float_as_uint(cA[ob][r]), __ATOMIC_RELAXED, __HIP_MEMORY_SCOPE_AGENT);
                __hip_atomic_store(sh + 4 * ob + r, __float_as_uint(cH[ob][r]), __ATOMIC_RELAXED, __HIP_MEMORY_SCOPE_AGENT);
            }
        }
    }
    asm volatile("s_waitcnt vmcnt(0) lgkmcnt(0)" ::: "memory");
    __syncthreads();
    if (tid_t == 0) __hip_atomic_store(FLAG + 16 * u, 1u, __ATOMIC_RELAXED, __HIP_MEMORY_SCOPE_AGENT);
    if (tid_t < c) {
        unsigned sp = 0;
        while (__hip_atomic_load(FLAG + 16 * (b * 32 + tid_t), __ATOMIC_RELAXED, __HIP_MEMORY_SCOPE_AGENT) == 0u) { __builtin_amdgcn_s_sleep(1); if (++sp > (1u << 22)) break; }
    }
    __syncthreads();
    {
        float H = 0.f;
        for (int c0 = 0; c0 < c; c0 += 32) {
            float sa[32], sh[32];
#pragma unroll
            for (int q = 0; q < 32; ++q) { const int cp = (c0 + q < c) ? (c0 + q) : 0; const unsigned* sp_ = (const unsigned*)SUMM + ((size_t)(b * 32 + cp) * 2) * 512 + tid_t;
                if (xl) { sa[q] = __uint_as_float(sp_[0]); sh[q] = __uint_as_float(sp_[512]); }
                else { sa[q] = __uint_as_float(__hip_atomic_load(sp_, __ATOMIC_RELAXED, __HIP_MEMORY_SCOPE_AGENT)); sh[q] = __uint_as_float(__hip_atomic_load(sp_ + 512, __ATOMIC_RELAXED, __HIP_MEMORY_SCOPE_AGENT)); } }
#pragma unroll
            for (int q = 0; q < 32; ++q) if (c0 + q < c) H = sa[q] * H + sh[q];
        }
        Hs[tid_t] = H;
    }
    __syncthreads();
    {
        const f32x4 H0 = *(const LAS f32x4*)(Hs + 8 * lane_t), H1 = *(const LAS f32x4*)(Hs + 8 * lane_t + 4);
        const f32x4 g0 = *(const f32x4*)(g_lru + 8 * lane_t), g1 = *(const f32x4*)(g_lru + 8 * lane_t + 4);
#pragma unroll
        for (int j = 0; j < 8; ++j) {
            const int tk = 8 * wid + j; const size_t row = (size_t)b * SEQ + 64 * c + tk;
            const u32x4 hlw = *(const LAS u32x4*)(HLs + tk * HSTR + 8 * lane_t), acw = *(const LAS u32x4*)(ACs + tk * HSTR + 8 * lane_t), lgw = *(const u32x4*)(PROJ + row * INW + LGOFF + 8 * lane_t);
            const f32x4 hl0 = (f32x4){bf_lo(hlw.x), bf_hi(hlw.x), bf_lo(hlw.y), bf_hi(hlw.y)}, hl1 = (f32x4){bf_lo(hlw.z), bf_hi(hlw.z), bf_lo(hlw.w), bf_hi(hlw.w)};
            const f32x4 ac0 = (f32x4){bf_lo(acw.x), bf_hi(acw.x), bf_lo(acw.y), bf_hi(acw.y)}, ac1 = (f32x4){bf_lo(acw.z), bf_hi(acw.z), bf_lo(acw.w), bf_hi(acw.w)};
            const f32x4 lg0 = (f32x4){bf_lo(lgw.x), bf_hi(lgw.x), bf_lo(lgw.y), bf_hi(lgw.y)}, lg1 = (f32x4){bf_lo(lgw.z), bf_hi(lgw.z), bf_lo(lgw.w), bf_hi(lgw.w)};
            const f32x4 v0 = (hl0 + ac0 * H0) * gelu_tanh4(lg0), v1 = (hl1 + ac1 * H1) * gelu_tanh4(lg1);
            const f32x4 q = v0 * v0 + v1 * v1;
            const float rs = __builtin_amdgcn_rsqf(wave_sum((q.x + q.y) + (q.z + q.w)) * (1.f / 512.f) + RMS_EPS);
            const f32x4 o0 = v0 * rs * g0, o1 = v1 * rs * g1;
            u32x4 w;
            w.x = cvt_pk_bf16(o0.x, o0.y); w.y = cvt_pk_bf16(o0.z, o0.w); w.z = cvt_pk_bf16(o1.x, o1.y); w.w = cvt_pk_bf16(o1.z, o1.w);
            *(u32x4*)(MERGED + row * DM + 512 + 8 * lane_t) = w;
        }
    }
    __syncthreads();
}

__device__ __forceinline__ void lru_final_unit(LAS unsigned char* lds, const bf16_t* PROJ, const bf16_t* HL, const bf16_t* ACUM, const float* SUMM, const float* g_lru, bf16_t* MERGED,
                                               int u, int tid, int wid, int lane) {
    const int b = u >> 5, c = u & 31;
    LAS float* Hs = (LAS float*)lds;
    {
        float H = 0.f;
        for (int c0 = 0; c0 < c; c0 += 16) {
            float sa[16], sh[16];
#pragma unroll
            for (int q = 0; q < 16; ++q) { const int cp = (c0 + q < c) ? (c0 + q) : 0; const float* s = SUMM + ((size_t)(b * 32 + cp) * 2) * 512 + tid; sa[q] = s[0]; sh[q] = s[512]; }
#pragma unroll
            for (int q = 0; q < 16; ++q) if (c0 + q < c) H = sa[q] * H + sh[q];
        }
        Hs[tid] = H;
    }
    __syncthreads();
    const f32x4 H0 = *(const LAS f32x4*)(Hs + 8 * lane), H1 = *(const LAS f32x4*)(Hs + 8 * lane + 4);
    const f32x4 g0 = *(const f32x4*)(g_lru + 8 * lane), g1 = *(const f32x4*)(g_lru + 8 * lane + 4);
#pragma unroll
    for (int j = 0; j < 8; ++j) {
        const size_t row = (size_t)b * SEQ + 64 * c + 8 * wid + j;
        const u32x4 hlw = *(const u32x4*)(HL + row * 512 + 8 * lane), acw = *(const u32x4*)(ACUM + row * 512 + 8 * lane), lgw = *(const u32x4*)(PROJ + row * INW + LGOFF + 8 * lane);
        float v[8]; float ssq = 0.f;
#pragma unroll
        for (int e = 0; e < 8; ++e) {
            const unsigned hw = hlw[e >> 1], aw = acw[e >> 1], gw = lgw[e >> 1];
            const float hl = (e & 1) ? bf_hi(hw) : bf_lo(hw), ac = (e & 1) ? bf_hi(aw) : bf_lo(aw), lg = (e & 1) ? bf_hi(gw) : bf_lo(gw);
            const float Hc = e < 4 ? H0[e & 3] : H1[e & 3];
            const float hv = hl + ac * Hc;
            v[e] = hv * gelu_tanh(lg); ssq += v[e] * v[e];
        }
        const float rs = 1.0f / sqrtf(wave_sum(ssq) * (1.f / 512.f) + RMS_EPS);
        u32x4 w;
        w.x = cvt_pk_bf16(v[0] * rs * g0.x, v[1] * rs * g0.y); w.y = cvt_pk_bf16(v[2] * rs * g0.z, v[3] * rs * g0.w);
        w.z = cvt_pk_bf16(v[4] * rs * g1.x, v[5] * rs * g1.y); w.w = cvt_pk_bf16(v[6] * rs * g1.z, v[7] * rs * g1.w);
        *(u32x4*)(MERGED + row * DM + 512 + 8 * lane) = w;
    }
    __syncthreads();
}

#define XB_TMO      128
#define XB_XCNT(j)  (256  + 64 * (j))
#define XB_XSUB(j)  (1280 + 64 * (j))
#define XB_XGEN(j)  (2304 + 64 * (j))
#define XB_TOP      3328
#define XB_TOPGEN   3392
#define XCD_BAR_WORDS 3456
#define XB_SPIN_CAP (1u << 18)
__device__ __forceinline__ unsigned xb_ld(unsigned* p)              { return __hip_atomic_load(p, __ATOMIC_RELAXED, __HIP_MEMORY_SCOPE_AGENT); }
__device__ __forceinline__ unsigned xb_add(unsigned* p, unsigned v) { return __hip_atomic_fetch_add(p, v, __ATOMIC_RELAXED, __HIP_MEMORY_SCOPE_AGENT); }
__device__ __forceinline__ unsigned xb_xcc_id() { return (unsigned)__builtin_amdgcn_s_getreg((3 << 11) | 20) & 0xFu; }
#define XB_SPIN(cond, bar) do { unsigned _sp = 0; while (cond) { __builtin_amdgcn_s_sleep(1); \
    if ((++_sp & 255u) == 0u) { if (xb_ld(&(bar)[XB_TMO])) break; if (_sp > XB_SPIN_CAP) { atomicAdd(&(bar)[XB_TMO], 1u); break; } } } } while (0)
#define SEAM(k) SEAM2(k, (k) + 1)
struct XcdBarrier { unsigned* bar; unsigned x; volatile LAS unsigned* st; };
__device__ __forceinline__ XcdBarrier xcd_barrier_post(unsigned* bar, volatile LAS unsigned* st) {
    XcdBarrier b; b.bar = bar; b.x = xb_xcc_id(); b.st = st;
    if (threadIdx.x == 0) st[2] = xb_add(&bar[XB_XCNT(b.x)], 1u);
    return b;
}
__device__ __forceinline__ void xcd_barrier_complete(unsigned* bar, unsigned x, unsigned& nloc, unsigned& nx) {
    const unsigned G = gridDim.x * gridDim.y * gridDim.z;
    unsigned sum, cnt, mine, sp = 0u;
    for (;;) {
        sum = 0u; cnt = 0u; mine = 0u;
#pragma unroll
        for (unsigned j = 0; j < 16; ++j) { const unsigned c = xb_ld(&bar[XB_XCNT(j)]); sum += c; cnt += (c > 0u) ? 1u : 0u; mine = (j == x) ? c : mine; }
        if (sum == G) break;
        __builtin_amdgcn_s_sleep(1);
        if ((++sp & 255u) == 0u) { if (xb_ld(&bar[XB_TMO])) break; if (sp > XB_SPIN_CAP) { atomicAdd(&bar[XB_TMO], 1u); break; } }
    }
    nloc = mine > 0u ? mine : 1u; nx = cnt > 0u ? cnt : 1u;
}
__device__ __forceinline__ void xcd_barrier(const XcdBarrier& b) {
    asm volatile("s_waitcnt vmcnt(0)" ::: "memory");
    __syncthreads();
    if (threadIdx.x == 0) {
        unsigned* bar = b.bar;
        __builtin_amdgcn_s_waitcnt(0);
        unsigned nloc = b.st[0], nx = b.st[1];
        if (nloc == 0u) { xcd_barrier_complete(bar, b.x, nloc, nx); b.st[0] = nloc; b.st[1] = nx; }
        const unsigned old = xb_add(&bar[XB_XSUB(b.x)], 1u);
        const unsigned gen = old / nloc;
        if (old + 1u == (gen + 1u) * nloc) {
            __builtin_amdgcn_fence(__ATOMIC_RELEASE, "agent");
            asm volatile("s_waitcnt vmcnt(0)" ::: "memory");
            const unsigned og = xb_add(&bar[XB_TOP], 1u);
            const unsigned tg = og / nx;
            if (og + 1u == (tg + 1u) * nx) xb_add(&bar[XB_TOPGEN], 1u);
            else XB_SPIN(xb_ld(&bar[XB_TOPGEN]) == tg, bar);
            __builtin_amdgcn_fence(__ATOMIC_ACQUIRE, "agent");
            xb_add(&bar[XB_XGEN(b.x)], 1u);
            asm volatile("s_waitcnt vmcnt(0)" ::: "memory");
        } else {
            XB_SPIN(xb_ld(&bar[XB_XGEN(b.x)]) == gen, bar);
            __builtin_amdgcn_fence(__ATOMIC_ACQUIRE, "agent");
            asm volatile("s_waitcnt vmcnt(0)" ::: "memory");
        }
    }
    __syncthreads();
}

#define XL_SUB(j) (3456 + 32 * (j))
#define XL_GEN(j) (3456 + 256 + 32 * (j))
__device__ __forceinline__ void xcc_local_barrier(const XcdBarrier& b) {
    asm volatile("s_waitcnt vmcnt(0)" ::: "memory");
    __syncthreads();
    if (threadIdx.x == 0) {
        unsigned* bar = b.bar;
        __builtin_amdgcn_s_waitcnt(0);
        const unsigned nloc = b.st[0];
        const unsigned old = xb_add(&bar[XL_SUB(b.x)], 1u);
        const unsigned gen = old / nloc;
        if (old + 1u == (gen + 1u) * nloc) xb_add(&bar[XL_GEN(b.x)], 1u);
        else XB_SPIN(xb_ld(&bar[XL_GEN(b.x)]) == gen, bar);
        __builtin_amdgcn_fence(__ATOMIC_ACQUIRE, "agent");
        asm volatile("s_waitcnt vmcnt(0)" ::: "memory");
    }
    __syncthreads();
}

struct Args { const float* in[21]; float* out; unsigned char* ws; int ph_lo, ph_hi; };
constexpr int N_PHASES = 10;

__global__ void __launch_bounds__(512, 2) mk_fwd(Args a) {
    extern __shared__ __attribute__((aligned(16))) unsigned char lds_raw[];
    LAS unsigned char* lds = (LAS unsigned char*)lds_raw;
    const int tid = threadIdx.x, lane = tid & 63, wid = __builtin_amdgcn_readfirstlane(tid >> 6);
    const int G = gridDim.x, bid = blockIdx.x;
    const int gw = bid * 8 + wid, NGW = G * 8;
    unsigned char* ws = a.ws;
    const float* x = a.in[0];
    bf16_t* WinT = (bf16_t*)(ws + WS_WIN); bf16_t* WoutT = (bf16_t*)(ws + WS_WOUT); bf16_t* WupT = (bf16_t*)(ws + WS_WUP); bf16_t* WdnT = (bf16_t*)(ws + WS_WDN);
    bf16_t* WaT = (bf16_t*)(ws + WS_WAT); bf16_t* WxT = WaT + 8 * 64 * 64; float* SP = (float*)(ws + WS_WAT + 131072);
    float* SUMM = (float*)(ws + WS_SUMM);
    bf16_t* HN = (bf16_t*)(ws + WS_HN); bf16_t* PROJ = (bf16_t*)(ws + WS_R1); float* Y = (float*)(ws + WS_R1);
    bf16_t* MERGED = (bf16_t*)(ws + WS_MERGED); bf16_t* HL = (bf16_t*)(ws + WS_HL); bf16_t* ACUM = (bf16_t*)(ws + WS_ACUM);
    bf16_t* GB = (bf16_t*)(ws + WS_G); bf16_t* EDGE = (bf16_t*)(ws + WS_EDGE);
    float* RS1 = (float*)(ws + WS_XB + 3 * M * 4 * 4); float* RS2 = RS1 + M;
    float* out = a.out; bf16_t* X1B = (bf16_t*)(ws + WS_MERGED);
    unsigned* XB0 = (unsigned*)(ws + WS_XB); unsigned* XB1 = XB0 + M * 4; unsigned* XB2 = XB1 + M * 4;
    unsigned* WUPCNT = (unsigned*)ws + 4032;
    unsigned* CNT0 = (unsigned*)(ws + 16384); unsigned* CNT1 = CNT0 + 64 * 64; unsigned* CNT2 = CNT1 + 64 * 64; unsigned* CNT3 = CNT2 + 64 * 64; unsigned* FLAGS = CNT3 + 64 * 64;
    const int lo = a.ph_lo, hi = a.ph_hi;
    volatile LAS unsigned* MISC = (volatile LAS unsigned*)(lds + LDS_BYTES - 256);
    if (tid < 32) MISC[tid] = 0u;
    __syncthreads();
    XcdBarrier bar; bar.bar = (unsigned*)ws; bar.x = 0; bar.st = MISC + 8;
    if (hi - lo > 1) bar = xcd_barrier_post((unsigned*)ws, MISC + 8);
#ifndef PH_MASK
#define PH_MASK 0x3ff
#endif
#define IN(k) (((PH_MASK >> (k)) & 1) && lo <= (k) && (k) < hi)
#ifndef PROBE_DUP
#define PROBE_DUP 0x0
#endif
#define REP(k) for (int rep_ = 0; rep_ < ((((PROBE_DUP) >> (k)) & 1) ? 3 : 1); ++rep_)
#ifndef PROBE_SYNC
#define PROBE_SYNC 0
#endif
#define SEAM2(k, k2) do { if (IN(k) && IN(k2)) { xcd_barrier(bar); if (PROBE_SYNC && (k) == 0) for (int q_ = 0; q_ < 10; ++q_) xcd_barrier(bar); } } while (0)

    if (IN(0)) REP(0) {
        LAS float* scr = (LAS float*)(lds + wid * 16640);
        constexpr int I_IN = (DM / 64) * (INW / 64), I_OUT = (DM / 64) * (DM / 64), I_DN = (DFF / 64) * (DM / 64);
        for (int it = gw; it < I_IN + I_OUT + I_DN; it += NGW) {
            int r = it;
            if (r < I_IN) { p0_transpose_item<false>(a.in[2], DM, INW, WinT, scr, r, lane, a.in[1]); continue; } r -= I_IN;
            if (r < I_OUT) { p0_transpose_item<false>(a.in[13], DM, DM, WoutT, scr, r, lane); continue; } r -= I_OUT;
            p0_transpose_item<false>(a.in[19], DFF, DM, WdnT, scr, r, lane);
        }
        for (int i = bid * 512 + tid; i < 2 * 8 * 64 * 64; i += G * 512) {
            const int mat = i >> 15, r = i & 32767, hh = r >> 12, o = (r >> 6) & 63, ii = r & 63;
            const float v = (mat ? a.in[8] : a.in[6])[(hh * 64 + ii) * 64 + o];
            (mat ? WxT : WaT)[r] = (bf16_t)(cvt_pk_bf16(v, 0.f) & 0xffffu);
        }
        for (int i = bid * 512 + tid; i < 512; i += G * 512) SP[i] = log1pf(expf(-a.in[10][i]));
        for (int m = gw; m < M; m += NGW) row_to_bf16_rs(x + (size_t)m * DM, HN + (size_t)m * DM, RS1 + m, lane);
        __syncthreads();
    }
    SEAM(0);
    int vb = bid; bool xlocal = false;
    if (hi - lo > 1) {
        if (tid == 0) {
            bool ok = (G == 256);
            for (unsigned j = 0; j < 16; ++j) { const unsigned cn = xb_ld(&bar.bar[XB_XCNT(j)]); ok = ok && (cn == (j < 8 ? (unsigned)(G / 8) : 0u)); }
            MISC[3 + 8] = ok ? 1u : 0u;
        }
        __syncthreads();
        xlocal = MISC[3 + 8] != 0u;
        if (xlocal) vb = (int)MISC[2 + 8] * 8 + (int)bar.x;
    }
    vb = __builtin_amdgcn_readfirstlane(vb);
#define SEAML(k, k2) do { if (IN(k) && IN(k2)) { if (xlocal) xcc_local_barrier(bar); else xcd_barrier(bar); } } while (0)
    if (IN(1)) REP(1) {
        pg8::Gemm g{HN, WinT, M, INW, DM}; pg8::StaticOrder S; S.init(M, INW, G, vb);
        pg8::EpiBf16 E{PROJ, INW, RS1};
        pg8::gemm_phase<pg8::EpiBf16, pg8::StaticOrder, true, true>(lds, g, S, E);
        {
            constexpr int NU = (M / 256) * (INW / 256);
            const bool split = (G < NU) && (2 * G > NU);
            const int f0 = split ? (NU - G) : 0, nf = G - f0;
            if (vb >= f0) {
                LAS float* scr = (LAS float*)(lds + wid * 16640);
                constexpr int I_UP = (DM / 64) * (NUP / 64);
                for (int it = (vb - f0) * 8 + wid; it < I_UP; it += nf * 8) p0_transpose_item<true, true>(a.in[16], DM, NUP, WupT, scr, it, lane, a.in[15]);
                asm volatile("s_waitcnt vmcnt(0)" ::: "memory");
                __syncthreads();
                if (tid == 0) __hip_atomic_fetch_add(WUPCNT, 1u, __ATOMIC_RELAXED, __HIP_MEMORY_SCOPE_AGENT);
            }
        }
    }
    SEAML(1, 2);
    if (IN(2)) REP(2) {
#ifndef NO_ATTN
        { const int u = (vb & 7) * 32 + (vb >> 3); attn_unit(lds, PROJ, MERGED, a.in[3], a.in[11], u, tid, wid, lane); }
#endif
#ifndef NO_LRU
        { const int u = (vb & 7) * 32 + (vb >> 3); lru_unit(lds, PROJ, WaT, WxT, a.in[4], a.in[5], a.in[7], a.in[9], SP, SUMM, FLAGS, a.in[12], MERGED, xlocal, u, tid, wid, lane); }
#endif
    }
    SEAML(2, 4);
    if (IN(4)) REP(4) {
        pg8::Gemm g{MERGED, WoutT, M, DM, DM}; pg8::StaticOrder S; S.init(M, DM, G, vb);
        pg8::PanelRms st1{XB0, CNT0}, st2{XB1, CNT1};
        pg8::EpiRmsResRms E{HN, X1B, (float*)XB1, a.in[14], st1, st2};
        pg8::gemm_phase<pg8::EpiRmsResRms, pg8::StaticOrder, false, true>(lds, g, S, E);
    }
    SEAML(4, 6);
    if (IN(6)) REP(6) {
        {
            constexpr int NU1 = (M / 256) * (INW / 256);
            const unsigned want = (unsigned)(((G < NU1) && (2 * G > NU1)) ? (2 * G - NU1) : G);
            if (tid == 0) { unsigned sp = 0; while (__hip_atomic_load(WUPCNT, __ATOMIC_RELAXED, __HIP_MEMORY_SCOPE_AGENT) < want) { __builtin_amdgcn_s_sleep(1); if (++sp > (1u << 22)) break; } }
            __syncthreads();
        }
        pg8::Gemm g{X1B, WupT, M, NUP, DM}; pg8::HalfTailOrder S; S.init(M, NUP, G, vb);
        pg8::EpiConvGate E{GB, EDGE, a.in[17], a.in[18], (const float*)XB1};
        pg8::gemm_phase<pg8::EpiConvGate, pg8::HalfTailOrder, true, true>(lds, g, S, E);
    }
    SEAML(6, 8);
    if (IN(8)) REP(8) {
        pg8::Gemm g{GB, WdnT, M, DM, DFF}; pg8::StaticOrder S; S.init(M, DM, G, vb);
        {
            const float* cw = a.in[17]; const float* cb = a.in[18];
            pg8::Unit uu;
            if (S.next(0, uu)) {
                const int B = 4 * uu.pm + uu.pn;
                const bool zero = (B % 32) == 0; const int Bp = zero ? B : B - 1;
#pragma unroll 3
                for (int idx = tid; idx < 2 * (DFF / 4); idx += 512) {
                    const int rsel = idx >= (DFF / 4) ? 1 : 0, ch = 4 * (idx - rsel * (DFF / 4));
                    f32x4 cv[2];
#pragma unroll
                    for (int gv = 0; gv < 2; ++gv) {
                        const int col = gv * DFF + ch;
                        const u32x2 r2 = *(const u32x2*)(EDGE + ((size_t)(Bp * 4 + 2) * 2 + gv) * DFF + ch), r1 = *(const u32x2*)(EDGE + ((size_t)(Bp * 4 + 3) * 2 + gv) * DFF + ch);
                        const u32x2 q0 = *(const u32x2*)(EDGE + ((size_t)(B * 4 + 0) * 2 + gv) * DFF + ch), q1 = *(const u32x2*)(EDGE + ((size_t)(B * 4 + 1) * 2 + gv) * DFF + ch);
                        f32x4 fm2 = (f32x4){bf_lo(r2.x), bf_hi(r2.x), bf_lo(r2.y), bf_hi(r2.y)}, fm1 = (f32x4){bf_lo(r1.x), bf_hi(r1.x), bf_lo(r1.y), bf_hi(r1.y)};
                        if (zero) { fm2 = (f32x4){0.f, 0.f, 0.f, 0.f}; fm1 = fm2; }
                        const f32x4 f0 = (f32x4){bf_lo(q0.x), bf_hi(q0.x), bf_lo(q0.y), bf_hi(q0.y)}, f1 = (f32x4){bf_lo(q1.x), bf_hi(q1.x), bf_lo(q1.y), bf_hi(q1.y)};
                        const f32x4 w0 = *(const f32x4*)(cw + col), w1 = *(const f32x4*)(cw + NUP + col), w2 = *(const f32x4*)(cw + 2 * NUP + col), bb = *(const f32x4*)(cb + col);
                        cv[gv] = rsel == 0 ? (w0 * fm2 + w1 * fm1 + w2 * f0 + bb) : (w0 * fm1 + w1 * f0 + w2 * f1 + bb);
                    }
                    const f32x4 go = gelu_tanh4(cv[0]) * cv[1];
                    u32x2 w; w.x = cvt_pk_bf16(go.x, go.y); w.y = cvt_pk_bf16(go.z, go.w);
                    *(u32x2*)(GB + (size_t)(64 * B + rsel) * DFF + ch) = w;
                }
                asm volatile("s_waitcnt vmcnt(0)" ::: "memory");
                __syncthreads();
                if (tid == 0) {
                    if (!xlocal) { __builtin_amdgcn_fence(__ATOMIC_RELEASE, "agent"); asm volatile("s_waitcnt vmcnt(0)" ::: "memory"); }
                    __hip_atomic_fetch_add(CNT3 + 64 * uu.pm, 1u, __ATOMIC_RELAXED, __HIP_MEMORY_SCOPE_AGENT);
                    unsigned sp = 0;
                    while (__hip_atomic_load(CNT3 + 64 * uu.pm, __ATOMIC_RELAXED, __HIP_MEMORY_SCOPE_AGENT) < 4u) { __builtin_amdgcn_s_sleep(1); if (++sp > (1u << 22)) break; }
                    __builtin_amdgcn_fence(__ATOMIC_ACQUIRE, "agent");
                    asm volatile("s_waitcnt vmcnt(0)" ::: "memory");
                }
                __syncthreads();
            }
        }
        pg8::PanelRms st{XB2, CNT2};
        pg8::EpiRmsRes E{X1B, out, a.in[20], st};
        pg8::gemm_phase<pg8::EpiRmsRes, pg8::StaticOrder, false, true>(lds, g, S, E);
    }
#undef IN
#undef SEAM
}

extern "C" void kernel_launch(void* const* d_in, const int* in_sizes, int n_in, void* d_out, int out_size, void* d_ws, size_t ws_size, hipStream_t stream) {
    static int grid = 0;
    if (grid == 0) {
        if (n_in != 21 || out_size != M * DM || ws_size < WS_END) { fprintf(stderr, "kernel_launch: unexpected problem shape (n_in %d out %d ws %zu)\n", n_in, out_size, ws_size); grid = -1; return; }
        int dev = 0, cus = 0, per_cu = 0;
        hipGetDevice(&dev); hipDeviceGetAttribute(&cus, hipDeviceAttributeMultiprocessorCount, dev);
        if (hipFuncSetAttribute((const void*)mk_fwd, hipFuncAttributeMaxDynamicSharedMemorySize, LDS_BYTES) != hipSuccess) { fprintf(stderr, "kernel_launch: hipFuncSetAttribute failed\n"); grid = -1; return; }
        if (hipOccupancyMaxActiveBlocksPerMultiprocessor(&per_cu, (const void*)mk_fwd, 512, LDS_BYTES) != hipSuccess || per_cu < 1) { fprintf(stderr, "kernel_launch: occupancy query says %d\n", per_cu); per_cu = 1; }
        (void)hipGetLastError();
        grid = cus * 1;
        if (grid > 256) grid = 256;
    }
    if (grid < 0) return;
    Args a{};
    for (int i = 0; i < 21; ++i) a.in[i] = (const float*)d_in[i];
    a.out = (float*)d_out; a.ws = (unsigned char*)d_ws;
#if MK_N_LAUNCHES == 1
    if (hipMemsetAsync(d_ws, 0, 16384 + 4 * 64 * 64 * 4 + 256 * 16 * 4, stream) != hipSuccess) { fprintf(stderr, "kernel_launch: memset failed\n"); return; }
    a.ph_lo = 0; a.ph_hi = N_PHASES;
    void* args[] = {&a};
    hipError_t e = hipLaunchCooperativeKernel((const void*)mk_fwd, dim3(grid), dim3(512), args, LDS_BYTES, stream);
    if (e != hipSuccess) fprintf(stderr, "cooperative launch failed: %s (grid %d)\n", hipGetErrorString(e), grid);
#else
    for (int p = 0; p < N_PHASES; ++p) { a.ph_lo = p; a.ph_hi = p + 1; hipLaunchKernelGGL(mk_fwd, dim3(grid), dim3(512), LDS_BYTES, stream, a); }
#endif
}
```
